# Optimizing an MI355X kernel written in HIP

```python
import math
import jax, jax.numpy as jnp
from jax import lax
import numpy as np

D_MODEL = 1024
BATCH = 2
SEQ = 8192
DEPTH = 2
DEC_BATCH = 128
DEC_SEQ = 1
PAST_LEN = 8192
PAGE_SIZE = 128

N_A = DEPTH // 2
N_B = DEPTH - N_A
M_HEADS = 4
M_DK = 128
M_DV = 256
M_CHUNK = 64
M_IN = 2 * M_HEADS * M_DK + 2 * M_HEADS * M_DV + 2 * M_HEADS
D_FF = 2816
CONV_W = 3
MLA_HEADS = 16
Q_LORA = 384
KV_LORA = 256
QK_NOPE = 64
QK_ROPE = 32
V_HEAD = 64
ROPE_THETA = 10000.0
Q_BLOCK = 128
ATT_SCALE = (QK_NOPE + QK_ROPE) ** -0.5
EPS = 1e-6

kernel_name = 'yoco_mlstm_mla_convffn_adaln_step'


def rms_norm(x, g):
    xf = x.astype(jnp.float32)
    y = xf * lax.rsqrt(jnp.mean(xf * xf, axis=-1, keepdims=True) + EPS)
    return (y * g.astype(jnp.float32)).astype(x.dtype)


def ada_mod(c, w, b, n):
    mod = jax.nn.silu(c) @ w + b
    return jnp.split(mod[:, None, :], n, axis=-1)


def apply_rope(x, pos):
    half = x.shape[-1] // 2
    freq = ROPE_THETA ** (-jnp.arange(half, dtype=jnp.float32) / half)
    ang = pos.astype(jnp.float32)[:, None] * freq[None, :]
    cos = jnp.cos(ang)[None, :, None, :]
    sin = jnp.sin(ang)[None, :, None, :]
    xf = x.astype(jnp.float32)
    x1, x2 = xf[..., :half], xf[..., half:]
    return jnp.concatenate([x1 * cos - x2 * sin, x1 * sin + x2 * cos], axis=-1).astype(x.dtype)


def mlstm_chunkwise(q, k, v, log_i, log_f):
    bsz, nh, s, _ = q.shape
    nc = s // M_CHUNK
    qc = q.reshape(bsz, nh, nc, M_CHUNK, M_DK)
    kc = k.reshape(bsz, nh, nc, M_CHUNK, M_DK)
    vc = v.reshape(bsz, nh, nc, M_CHUNK, M_DV)
    li = log_i.reshape(bsz, nh, nc, M_CHUNK)
    b = jnp.cumsum(log_f.reshape(bsz, nh, nc, M_CHUNK), axis=-1)
    g = b[..., -1]
    a = g[..., None] - b + li
    m_loc = jnp.max(a, axis=-1)
    wa = jnp.exp(a - m_loc[..., None])
    c_loc = jnp.einsum('bhcld,bhcle->bhcde', kc * wa[..., None], vc)
    n_loc = jnp.einsum('bhcl,bhcld->bhcd', wa, kc)

    def chunk_step(carry, inp):
        c_st, n_st, m_st = carry
        g_c, m_l, c_l, n_l = inp
        m_new = jnp.maximum(g_c + m_st, m_l)
        fw = jnp.exp(g_c + m_st - m_new)
        lw = jnp.exp(m_l - m_new)
        c_new = fw[..., None, None] * c_st + lw[..., None, None] * c_l
        n_new = fw[..., None] * n_st + lw[..., None] * n_l
        return (c_new, n_new, m_new), (c_st, n_st, m_st)

    init = (jnp.zeros((bsz, nh, M_DK, M_DV), jnp.float32),
            jnp.zeros((bsz, nh, M_DK), jnp.float32),
            jnp.zeros((bsz, nh), jnp.float32))
    xs = (jnp.moveaxis(g, 2, 0), jnp.moveaxis(m_loc, 2, 0),
          jnp.moveaxis(c_loc, 2, 0), jnp.moveaxis(n_loc, 2, 0))
    final, (c_prev, n_prev, m_prev) = lax.scan(chunk_step, init, xs)
    c_prev = jnp.moveaxis(c_prev, 0, 2)
    n_prev = jnp.moveaxis(n_prev, 0, 2)
    m_prev = jnp.moveaxis(m_prev, 0, 2)
    w0 = b + m_prev[..., None]
    causal = jnp.tril(jnp.ones((M_CHUNK, M_CHUNK), bool))
    dmat = jnp.where(causal, b[..., :, None] - b[..., None, :] + li[..., None, :], -jnp.inf)
    m_s = jnp.maximum(w0, jnp.max(dmat, axis=-1))
    w_inter = jnp.exp(w0 - m_s)
    s_qk = jnp.einsum('bhcid,bhcjd->bhcij', qc, kc) * jnp.exp(dmat - m_s[..., None])
    num = (w_inter[..., None] * jnp.einsum('bhcid,bhcde->bhcie', qc, c_prev)
           + jnp.einsum('bhcij,bhcje->bhcie', s_qk, vc))
    den = w_inter * jnp.einsum('bhcid,bhcd->bhci', qc, n_prev) + jnp.sum(s_qk, axis=-1)
    h = num / jnp.maximum(jnp.abs(den), jnp.exp(-m_s))[..., None]
    return h.reshape(bsz, nh, s, M_DV), final


def mlstm_step(carry, inp):
    c_st, n_st, m_st = carry
    q, k, v, li, lf = inp
    m_new = jnp.maximum(lf + m_st, li)
    fw = jnp.exp(lf + m_st - m_new)
    iw = jnp.exp(li - m_new)
    c_new = fw[..., None, None] * c_st + iw[..., None, None] * (k[..., :, None] * v[..., None, :])
    n_new = fw[..., None] * n_st + iw[..., None] * k
    num = jnp.einsum('bhd,bhde->bhe', q, c_new)
    den = jnp.einsum('bhd,bhd->bh', q, n_new)
    h = num / jnp.maximum(jnp.abs(den), jnp.exp(-m_new))[..., None]
    return (c_new, n_new, m_new), h


def mlstm_recurrent(q, k, v, log_i, log_f, state):
    init = tuple(s_.astype(jnp.float32) for s_ in state)
    xs = (jnp.moveaxis(q, 2, 0), jnp.moveaxis(k, 2, 0), jnp.moveaxis(v, 2, 0),
          jnp.moveaxis(log_i, 2, 0), jnp.moveaxis(log_f, 2, 0))
    final, hs = lax.scan(mlstm_step, init, xs)
    return jnp.moveaxis(hs, 0, 2), final


def mlstm_mixer(h, w_in, b_gates, g_head, w_out, state):
    bsz, s, _ = h.shape
    qd, vd = M_HEADS * M_DK, M_HEADS * M_DV
    proj = h @ w_in
    q, k, v, o, gates = jnp.split(proj, [qd, 2 * qd, 2 * qd + vd, 2 * qd + 2 * vd], axis=-1)

    def heads(t, d):
        return t.reshape(bsz, s, M_HEADS, d).transpose(0, 2, 1, 3).astype(jnp.float32)

    q = heads(q, M_DK) * (M_DK ** -0.5)
    k = heads(k, M_DK)
    v = heads(v, M_DV)
    gates = (gates + b_gates).astype(jnp.float32).transpose(0, 2, 1)
    log_i = gates[:, :M_HEADS]
    log_f = jax.nn.log_sigmoid(gates[:, M_HEADS:])
    if state is None:
        hh, new_state = mlstm_chunkwise(q, k, v, log_i, log_f)
    else:
        hh, new_state = mlstm_recurrent(q, k, v, log_i, log_f, state)
    hh = rms_norm(hh.transpose(0, 2, 1, 3), g_head)
    hh = hh.reshape(bsz, s, vd).astype(h.dtype) * jax.nn.sigmoid(o)
    return hh @ w_out, new_state


def conv_ffn(h, buf, w_up, w_conv, b_conv, w_down):
    s = h.shape[1]
    a, gt = jnp.split(h @ w_up, 2, axis=-1)
    ext = jnp.concatenate([buf.astype(a.dtype), a], axis=1)
    conv = b_conv
    for j in range(CONV_W):
        conv = conv + ext[:, j:j + s] * w_conv[j]
    out = (jax.nn.silu(conv) * gt) @ w_down
    return out, ext[:, -(CONV_W - 1):]


def shared_latent(x, c, pos, g_kv_in, w_ada_kv, b_ada_kv, w_dkv, g_kv):
    shift, scale = ada_mod(c, w_ada_kv, b_ada_kv, 2)
    hn = rms_norm(x, g_kv_in) * (1 + scale) + shift
    lat = hn @ w_dkv
    ckv = rms_norm(lat[..., :KV_LORA], g_kv)
    kpe = apply_rope(lat[:, :, None, KV_LORA:], pos)[:, :, 0, :]
    return ckv, kpe


def mla_queries(h, pos, w_dq, g_q, w_uq):
    bsz, s, _ = h.shape
    q = (rms_norm(h @ w_dq, g_q) @ w_uq).reshape(bsz, s, MLA_HEADS, QK_NOPE + QK_ROPE)
    return q[..., :QK_NOPE], apply_rope(q[..., QK_NOPE:], pos)


def mla_attend_prompt(q_nope, q_pe, ckv, kpe, w_uk, w_uv):
    bsz, s, nh, _ = q_nope.shape
    nb = s // Q_BLOCK
    k_nope = jnp.einsum('bkc,chd->bkhd', ckv, w_uk)
    v = jnp.einsum('bkc,chd->bkhd', ckv, w_uv)
    k_pos = jnp.arange(s)

    def to_blocks(t):
        return jnp.moveaxis(t.reshape(bsz, nb, Q_BLOCK, nh, t.shape[-1]), 1, 0)

    def block(args):
        qn, qp, blk = args
        sc = jnp.einsum('bqhd,bkhd->bhqk', qn, k_nope) + jnp.einsum('bqhr,bkr->bhqk', qp, kpe)
        q_pos = blk * Q_BLOCK + jnp.arange(Q_BLOCK)
        sc = jnp.where(k_pos[None, :] <= q_pos[:, None], sc.astype(jnp.float32) * ATT_SCALE, -jnp.inf)
        p = jax.nn.softmax(sc, axis=-1).astype(v.dtype)
        return jnp.einsum('bhqk,bkhd->bqhd', p, v)

    o = lax.map(block, (to_blocks(q_nope), to_blocks(q_pe), jnp.arange(nb)))
    return jnp.moveaxis(o, 0, 1).reshape(bsz, s, nh * V_HEAD)


def mla_attend_sample(q_nope, q_pe, ckv_past, kpe_past, ckv_new, kpe_new, w_uk, w_uv):
    bsz, t, nh, _ = q_nope.shape
    n_past = ckv_past.shape[1]
    q_lat = jnp.einsum('bqhd,chd->bqhc', q_nope, w_uk)
    s_past = jnp.einsum('bqhc,bkc->bhqk', q_lat, ckv_past) + jnp.einsum('bqhr,bkr->bhqk', q_pe, kpe_past)
    s_new = jnp.einsum('bqhc,bkc->bhqk', q_lat, ckv_new) + jnp.einsum('bqhr,bkr->bhqk', q_pe, kpe_new)
    causal = jnp.tril(jnp.ones((t, t), bool))
    s_new = jnp.where(causal, s_new.astype(jnp.float32) * ATT_SCALE, -jnp.inf)
    sc = jnp.concatenate([s_past.astype(jnp.float32) * ATT_SCALE, s_new], axis=-1)
    p = jax.nn.softmax(sc, axis=-1).astype(ckv_new.dtype)
    o_lat = (jnp.einsum('bhqk,bkc->bqhc', p[..., :n_past], ckv_past)
             + jnp.einsum('bhqk,bkc->bqhc', p[..., n_past:], ckv_new))
    o = jnp.einsum('bqhc,chd->bqhd', o_lat, w_uv)
    return o.reshape(bsz, t, nh * V_HEAD)


def trunk(x, c, pos, conv_bufs, m_states, kv_past,
          g_norm1, g_norm2, w_ada, b_ada, w_up, w_conv, b_conv, w_down,
          w_m_in, b_m_gates, g_m_head, w_m_out,
          g_kv_in, w_ada_kv, b_ada_kv, w_dkv, g_kv, w_uk, w_uv,
          w_dq, g_q, w_uq, w_o, g_final):
    new_c, new_n, new_m, new_conv = [], [], [], []
    ckv = kpe = None
    for layer in range(DEPTH):
        sh1, sc1, gt1, sh2, sc2, gt2 = ada_mod(c, w_ada[layer], b_ada[layer], 6)
        if layer == N_A:
            ckv, kpe = shared_latent(x, c, pos, g_kv_in, w_ada_kv, b_ada_kv, w_dkv, g_kv)
        hn = rms_norm(x, g_norm1[layer]) * (1 + sc1) + sh1
        if layer < N_A:
            st = None if m_states is None else (m_states[0][layer], m_states[1][layer], m_states[2][layer])
            mix, (c_st, n_st, m_st) = mlstm_mixer(hn, w_m_in[layer], b_m_gates[layer],
                                                  g_m_head[layer], w_m_out[layer], st)
            new_c.append(c_st)
            new_n.append(n_st)
            new_m.append(m_st)
        else:
            j = layer - N_A
            q_nope, q_pe = mla_queries(hn, pos, w_dq[j], g_q[j], w_uq[j])
            if kv_past is None:
                att = mla_attend_prompt(q_nope, q_pe, ckv, kpe, w_uk, w_uv)
            else:
                att = mla_attend_sample(q_nope, q_pe, kv_past[0], kv_past[1], ckv, kpe, w_uk, w_uv)
            mix = att @ w_o[j]
        x = x + gt1 * mix
        hn = rms_norm(x, g_norm2[layer]) * (1 + sc2) + sh2
        f, buf = conv_ffn(hn, conv_bufs[layer], w_up[layer], w_conv[layer], b_conv[layer], w_down[layer])
        new_conv.append(buf)
        x = x + gt2 * f
    y = rms_norm(x, g_final)
    return y, jnp.stack(new_c), jnp.stack(new_n), jnp.stack(new_m), jnp.stack(new_conv), ckv, kpe


def setup_inputs(seed: int = 0) -> dict:
    key = jax.random.key(seed)
    ks = iter(jax.random.split(key, 48))

    def nrm(shape, scale=1.0):
        return scale * jax.random.normal(next(ks), shape, jnp.float32)

    D = D_MODEL
    n_pages = PAST_LEN // PAGE_SIZE
    n_used = DEC_BATCH * n_pages
    n_phys = n_used + n_used // 4
    x_prompt = nrm((BATCH, SEQ, D))
    x_sample = nrm((DEC_BATCH, DEC_SEQ, D))
    state_mlstm_C = nrm((N_A, DEC_BATCH, M_HEADS, M_DK, M_DV))
    state_mlstm_n = nrm((N_A, DEC_BATCH, M_HEADS, M_DK))
    state_mlstm_m = nrm((N_A, DEC_BATCH, M_HEADS))
    state_conv = nrm((DEPTH, DEC_BATCH, CONV_W - 1, D_FF))
    cache_ckv = nrm((n_phys, PAGE_SIZE, KV_LORA))
    cache_kpe = nrm((n_phys, PAGE_SIZE, QK_ROPE))
    page_table = jax.random.permutation(next(ks), n_phys)[:n_used].reshape(DEC_BATCH, n_pages).astype(jnp.int32)
    c_prompt = nrm((BATCH, D))
    c_sample = nrm((DEC_BATCH, D))
    g_norm1 = 1.0 + nrm((DEPTH, D), 0.05)
    g_norm2 = 1.0 + nrm((DEPTH, D), 0.05)
    w_ada = nrm((DEPTH, D, 6 * D), 0.5 * D ** -0.5)
    b_ada = nrm((DEPTH, 6 * D), 0.01)
    w_up = nrm((DEPTH, D, 2 * D_FF), D ** -0.5)
    w_conv = nrm((DEPTH, CONV_W, D_FF), CONV_W ** -0.5)
    b_conv = nrm((DEPTH, D_FF), 0.01)
    w_down = nrm((DEPTH, D_FF, D), D_FF ** -0.5)
    w_m_in = nrm((N_A, D, M_IN), D ** -0.5)
    b_m_gates = jnp.concatenate([nrm((N_A, M_HEADS), 0.1), 3.0 + nrm((N_A, M_HEADS), 0.1)], axis=-1)
    g_m_head = 1.0 + nrm((N_A, M_HEADS, M_DV), 0.05)
    w_m_out = nrm((N_A, M_HEADS * M_DV, D), (M_HEADS * M_DV) ** -0.5)
    g_kv_in = 1.0 + nrm((D,), 0.05)
    w_ada_kv = nrm((D, 2 * D), 0.5 * D ** -0.5)
    b_ada_kv = nrm((2 * D,), 0.01)
    w_dkv = nrm((D, KV_LORA + QK_ROPE), D ** -0.5)
    g_kv = 1.0 + nrm((KV_LORA,), 0.05)
    w_uk = nrm((KV_LORA, MLA_HEADS, QK_NOPE), KV_LORA ** -0.5)
    w_uv = nrm((KV_LORA, MLA_HEADS, V_HEAD), KV_LORA ** -0.5)
    w_dq = nrm((N_B, D, Q_LORA), D ** -0.5)
    g_q = 1.0 + nrm((N_B, Q_LORA), 0.05)
    w_uq = nrm((N_B, Q_LORA, MLA_HEADS * (QK_NOPE + QK_ROPE)), Q_LORA ** -0.5)
    w_o = nrm((N_B, MLA_HEADS * V_HEAD, D), (MLA_HEADS * V_HEAD) ** -0.5)
    g_final = 1.0 + nrm((D,), 0.05)
    return {'x_prompt': x_prompt, 'x_sample': x_sample,
            'state_mlstm_C': state_mlstm_C, 'state_mlstm_n': state_mlstm_n, 'state_mlstm_m': state_mlstm_m,
            'state_conv': state_conv, 'cache_ckv': cache_ckv, 'cache_kpe': cache_kpe,
            'page_table': page_table, 'c_prompt': c_prompt, 'c_sample': c_sample,
            'g_norm1': g_norm1, 'g_norm2': g_norm2, 'w_ada': w_ada, 'b_ada': b_ada,
            'w_up': w_up, 'w_conv': w_conv, 'b_conv': b_conv, 'w_down': w_down,
            'w_m_in': w_m_in, 'b_m_gates': b_m_gates, 'g_m_head': g_m_head, 'w_m_out': w_m_out,
            'g_kv_in': g_kv_in, 'w_ada_kv': w_ada_kv, 'b_ada_kv': b_ada_kv, 'w_dkv': w_dkv, 'g_kv': g_kv,
            'w_uk': w_uk, 'w_uv': w_uv, 'w_dq': w_dq, 'g_q': g_q, 'w_uq': w_uq, 'w_o': w_o,
            'g_final': g_final}


def reference(x_prompt, x_sample, state_mlstm_C, state_mlstm_n, state_mlstm_m, state_conv,
              cache_ckv, cache_kpe, page_table, c_prompt, c_sample,
              g_norm1, g_norm2, w_ada, b_ada, w_up, w_conv, b_conv, w_down,
              w_m_in, b_m_gates, g_m_head, w_m_out,
              g_kv_in, w_ada_kv, b_ada_kv, w_dkv, g_kv, w_uk, w_uv,
              w_dq, g_q, w_uq, w_o, g_final):
    weights = (g_norm1, g_norm2, w_ada, b_ada, w_up, w_conv, b_conv, w_down,
               w_m_in, b_m_gates, g_m_head, w_m_out,
               g_kv_in, w_ada_kv, b_ada_kv, w_dkv, g_kv, w_uk, w_uv,
               w_dq, g_q, w_uq, w_o, g_final)
    bp, s, _ = x_prompt.shape
    bs, t, _ = x_sample.shape
    past_len = page_table.shape[1] * cache_ckv.shape[1]

    conv0 = jnp.zeros((DEPTH, bp, CONV_W - 1, D_FF), x_prompt.dtype)
    y_p, c_p, n_p, m_p, conv_p, ckv_p, kpe_p = trunk(
        x_prompt, c_prompt, jnp.arange(s), conv0, None, None, *weights)

    ckv_past = cache_ckv[page_table].reshape(bs, past_len, KV_LORA)
    kpe_past = cache_kpe[page_table].reshape(bs, past_len, QK_ROPE)
    y_s, c_s, n_s, m_s, conv_s, ckv_s, kpe_s = trunk(
        x_sample, c_sample, past_len + jnp.arange(t), state_conv,
        (state_mlstm_C, state_mlstm_n, state_mlstm_m), (ckv_past, kpe_past), *weights)

    return (y_p, y_s, c_p, n_p, m_p, conv_p, ckv_p, kpe_p, c_s, n_s, m_s, conv_s, ckv_s, kpe_s)
```

```cpp
#include <hip/hip_runtime.h>
#include <hip/hip_bf16.h>
#include <cstdio>
#include <cstdint>
#include <cmath>
namespace pg8 {
#define PG8_LAS __attribute__((address_space(3)))
typedef unsigned short bf16_t;
typedef short bf16x8 __attribute__((ext_vector_type(8)));
typedef float f32x4 __attribute__((ext_vector_type(4)));
typedef unsigned u32x4 __attribute__((ext_vector_type(4)));
constexpr int BM = 256, BK = 64, HALF = 128, HTB = HALF * BK * 2  , STAGE_BYTES = 8 * HTB, NXCD = 8, WGM = 8;

__host__ __device__ __forceinline__ int lds_byte(int r, int c) { const int st = (r >> 4) * 2 + (c >> 5), rr = r & 15, cc = c & 31, ob = rr * 64 + cc * 2; return st * 1024 + (ob ^ (((ob >> 9) & 1) << 5)); }
__host__ __device__ __forceinline__ void stage_rc(int b, int& R, int& C) { const int st = b / 1024, sb = b % 1024, swz = sb ^ (((sb >> 9) & 1) << 5); R = (st >> 1) * 16 + swz / 64; C = (st & 1) * 32 + (swz % 64) / 2; }
__host__ __device__ __forceinline__ int perm32(int rho) { const int n = rho >> 4, i = rho & 15; return 8 * (i >> 2) + 4 * n + (i & 3); }

struct Unit { int pm, pn; };
struct Gemm { const bf16_t* A; const bf16_t* Bt; int M, N, K; };

struct StaticOrder {
    int nM, nN, nwg, G, c;
    __host__ __device__ void init(int M, int N, int G_, int c_) { nM = M / BM; nN = N / BM; nwg = nM * nN; G = G_; c = c_; }
    __host__ __device__ bool next(int i, Unit& u) const {
        const long L = (long)i * G + c; if (L >= nwg) return false;
        int wgid = (int)L; { const int q = nwg / NXCD, r = nwg % NXCD, xcd = wgid % NXCD, off = wgid / NXCD; wgid = (xcd < r ? xcd * (q + 1) : r * (q + 1) + (xcd - r) * q) + off; }
        const int nig = WGM * nN, gid = wgid / nig, fm = gid * WGM, gsz = (nM - fm) < WGM ? (nM - fm) : WGM;
        u.pm = fm + ((wgid % nig) % gsz); u.pn = (wgid % nig) / gsz; return true;
    }
    __device__ __forceinline__ void a_ready(const Unit&) const {}
    __device__ __forceinline__ void done(const Unit&) const {}
};

__device__ __forceinline__ unsigned cvt_pk_bf16(float lo, float hi) { unsigned r; asm volatile("v_cvt_pk_bf16_f32 %0, %1, %2" : "=v"(r) : "v"(lo), "v"(hi)); return r; }
typedef float f32x2 __attribute__((ext_vector_type(2)));
__device__ __forceinline__ f32x2 gelu_pk(f32x2 v) {
    const f32x2 av = __builtin_elementwise_abs(v), d = av * 0.2316418882f + 1.0f;
    f32x2 t; t.x = __builtin_amdgcn_rcpf(d.x); t.y = __builtin_amdgcn_rcpf(d.y);
    f32x2 q = t * 0.5307027145f + (-0.7265760135f); q = q * t + 0.7107068705f; q = q * t + (-0.142248368f); q = q * t + 0.127414796f; q = q * t;
    const f32x2 s = (v * v) * (-0.72134752044f);
    f32x2 e; e.x = __builtin_amdgcn_exp2f(s.x); e.y = __builtin_amdgcn_exp2f(s.y);
    const f32x2 m = v * (q * e), r = v - m;
    f32x2 o; o.x = v.x < 0.f ? m.x : r.x; o.y = v.y < 0.f ? m.y : r.y; return o;
}

template <int ACT  > struct EpiBf16 {
    static constexpr bool PERM = true, AFTER_DRAIN = false; static_assert(ACT == 0 || ACT == 1, "EpiBf16: ACT is 0 (none) or 1 (gelu_pk)");
    bf16_t* O; int ldc; const float* bias; int split_cols; size_t split_stride; float scale0;
    __device__ __forceinline__ void operator()(const f32x4 (&acc)[2][2][4][2], const Unit& u, int wr, int wc, int fr, int fq) const {
        const int row0 = u.pm * BM + wr * 64 + fr; int colt = u.pn * BM; bf16_t* base = O;
        float sc = 1.f; if (split_cols) { const int t = colt / split_cols; base += (size_t)t * split_stride; colt -= t * split_cols; if (t == 0) sc = scale0; }
        const int col0 = colt + wc * 32 + 8 * fq, bcol0 = u.pn * BM + wc * 32 + 8 * fq;
        f32x4 bv[2][2];
#pragma unroll
        for (int bj = 0; bj < 2; ++bj)
#pragma unroll
            for (int n = 0; n < 2; ++n) bv[bj][n] = bias ? *(const f32x4*)(bias + bcol0 + bj * HALF + 4 * n) : (f32x4){0.f, 0.f, 0.f, 0.f};
#pragma unroll
        for (int ai = 0; ai < 2; ++ai)
#pragma unroll
            for (int m = 0; m < 4; ++m) { bf16_t* rowp = base + (size_t)(row0 + ai * HALF + m * 16) * ldc + col0;
#pragma unroll
                for (int bj = 0; bj < 2; ++bj) { f32x4 v0 = acc[ai][bj][m][0] + bv[bj][0], v1 = acc[ai][bj][m][1] + bv[bj][1];
                    if (ACT == 1) { f32x2 a = gelu_pk((f32x2){v0[0], v0[1]}), b = gelu_pk((f32x2){v0[2], v0[3]}), c = gelu_pk((f32x2){v1[0], v1[1]}), d = gelu_pk((f32x2){v1[2], v1[3]});
                        v0 = (f32x4){a.x, a.y, b.x, b.y}; v1 = (f32x4){c.x, c.y, d.x, d.y}; }
                    v0 = v0 * sc; v1 = v1 * sc; u32x4 w; w.x = cvt_pk_bf16(v0[0], v0[1]); w.y = cvt_pk_bf16(v0[2], v0[3]); w.z = cvt_pk_bf16(v1[0], v1[1]); w.w = cvt_pk_bf16(v1[2], v1[3]);
                    *(u32x4*)(rowp + bj * HALF) = w; } }
    }
};

struct PanelStats {
    unsigned* xbuf;
    unsigned* cnt;
    unsigned* tmo;
    int ntn; float eps;
    unsigned code;
    __device__ __forceinline__ bool run(const f32x4 (&v)[2][2][4][2], const Unit& u, int wr, int wc, int fr, int fq, PG8_LAS unsigned char* lds, int wid, int lane) const {
        typedef float f32x2v __attribute__((ext_vector_type(2)));
        PG8_LAS f32x2v* P = (PG8_LAS f32x2v*)lds;
        PG8_LAS f32x2v* S = (PG8_LAS f32x2v*)(lds + 8192);
        PG8_LAS unsigned* flag = (PG8_LAS unsigned*)(lds + 8192 + 2048);
#pragma unroll
        for (int ai = 0; ai < 2; ++ai)
#pragma unroll
            for (int m = 0; m < 4; ++m) {
                float s = 0.f;
#pragma unroll
                for (int bj = 0; bj < 2; ++bj)
#pragma unroll
                    for (int n = 0; n < 2; ++n) { const f32x4 x = v[ai][bj][m][n]; s += (x[0] + x[1]) + (x[2] + x[3]); }
                s += __shfl_xor(s, 16); s += __shfl_xor(s, 32);
                const float mw = s * (1.0f / 64.0f); float q = 0.f;
#pragma unroll
                for (int bj = 0; bj < 2; ++bj)
#pragma unroll
                    for (int n = 0; n < 2; ++n) { const f32x4 d = v[ai][bj][m][n] - mw; q += (d[0] * d[0] + d[1] * d[1]) + (d[2] * d[2] + d[3] * d[3]); }
                q += __shfl_xor(q, 16); q += __shfl_xor(q, 32);
                if (fq == 0) P[(ai * HALF + wr * 64 + m * 16 + fr) * 4 + wc] = (f32x2v){mw, q};
            }
        asm volatile("s_waitcnt lgkmcnt(0)" ::: "memory"); __builtin_amdgcn_s_barrier(); asm volatile("" ::: "memory");
#if defined(BROKEN_EXCHANGE_NO_WAIT)
#warning BROKEN CONTROL BUILD: the row-statistics exchange does not wait; results are wrong by design
        if (blockIdx.x >= 64) { const long long t0_ = clock64(); while (clock64() - t0_ < 60000) __builtin_amdgcn_s_sleep(8); }
#endif
        const int row = wid * 32 + (lane & 31);
        if (lane < 32) {
            const f32x2v a = P[row * 4 + 0], b = P[row * 4 + 1], c = P[row * 4 + 2], d = P[row * 4 + 3];
            const float mt = (a.x + b.x + c.x + d.x) * 0.25f;
            const float da = a.x - mt, db = b.x - mt, dc = c.x - mt, dd = d.x - mt;
            const float m2 = (a.y + b.y) + (c.y + d.y) + 64.0f * ((da * da + db * db) + (dc * dc + dd * dd));
            unsigned long long* slot = (unsigned long long*)xbuf + ((size_t)(u.pm * BM + row) * 4 + u.pn);
            __hip_atomic_store(slot, ((unsigned long long)__float_as_uint(m2) << 32) | __float_as_uint(mt), __ATOMIC_RELAXED, __HIP_MEMORY_SCOPE_AGENT);
        }
        asm volatile("s_waitcnt vmcnt(0)" ::: "memory");
        if (lane == 0) __hip_atomic_fetch_add(cnt + 64 * u.pm, 1u, __ATOMIC_RELAXED, __HIP_MEMORY_SCOPE_AGENT);
        if (wid == 0) {
            bool dead = false; const unsigned long long t0 = __builtin_amdgcn_s_memrealtime(); const unsigned want = 8u * (unsigned)ntn;
            for (;;) {
#if defined(BROKEN_EXCHANGE_NO_WAIT)
                break;
#endif
                if ((unsigned)__builtin_amdgcn_readfirstlane(__hip_atomic_load(cnt + 64 * u.pm, __ATOMIC_RELAXED, __HIP_MEMORY_SCOPE_AGENT)) >= want) break;
                if (__builtin_amdgcn_s_memrealtime() - t0 > 2000000ull) {
                    if (lane == 0) { unsigned expect = 0u; __hip_atomic_compare_exchange_strong(tmo + 1, &expect, code | (unsigned)(u.pm & 0xff), __ATOMIC_RELAXED, __ATOMIC_RELAXED, __HIP_MEMORY_SCOPE_AGENT);
                                     __hip_atomic_store(tmo, 1u, __ATOMIC_RELAXED, __HIP_MEMORY_SCOPE_AGENT); }
                    dead = true; break; }
                __builtin_amdgcn_s_sleep(2);
            }
            __builtin_amdgcn_fence(__ATOMIC_ACQUIRE, "agent");
            if (lane == 0) flag[0] = dead ? 1u : 0u;
        }
        asm volatile("s_waitcnt vmcnt(0) lgkmcnt(0)" ::: "memory"); __builtin_amdgcn_s_barrier(); asm volatile("" ::: "memory");
        const bool bad = flag[0] != 0u;
        if (lane < 32) {
            const unsigned long long* slot = (const unsigned long long*)xbuf + (size_t)(u.pm * BM + row) * 4; float mt[4], m2[4]; float ms = 0.f;
#pragma unroll
            for (int t = 0; t < 4; ++t) { if (t < ntn) { const unsigned long long w = __hip_atomic_load(slot + t, __ATOMIC_RELAXED, __HIP_MEMORY_SCOPE_AGENT); mt[t] = __uint_as_float((unsigned)w); m2[t] = __uint_as_float((unsigned)(w >> 32)); } else { mt[t] = 0.f; m2[t] = 0.f; } ms += mt[t]; }
            const float mean = ms / (float)ntn; float q = 0.f;
#pragma unroll
            for (int t = 0; t < 4; ++t) if (t < ntn) { const float dm = mt[t] - mean; q += m2[t] + 256.0f * dm * dm; }
            S[row] = (f32x2v){mean, 1.0f / sqrtf(q / (256.0f * (float)ntn) + eps)};
        }
        asm volatile("s_waitcnt lgkmcnt(0)" ::: "memory"); __builtin_amdgcn_s_barrier(); asm volatile("" ::: "memory");
        return bad;
    }
};
struct EpiLnRes {
    static constexpr bool PERM = false, AFTER_DRAIN = true;
    const float* base; float* out; int ldc; const float* bias; PanelStats st; unsigned poison;
    __device__ __forceinline__ void fused(f32x4 (&acc)[2][2][4][2], const Unit& u, int wr, int wc, int fr, int fq, PG8_LAS unsigned char* lds, int wid, int lane) const {
        typedef float f32x2v __attribute__((ext_vector_type(2)));
        const PG8_LAS f32x2v* S = (const PG8_LAS f32x2v*)(lds + 8192);
        const int col0 = u.pn * BM + wc * 32 + 4 * fq;
#pragma unroll
        for (int bj = 0; bj < 2; ++bj)
#pragma unroll
            for (int n = 0; n < 2; ++n) { const f32x4 bv = bias ? *(const f32x4*)(bias + col0 + bj * HALF + n * 16) : (f32x4){0.f, 0.f, 0.f, 0.f};
#pragma unroll
                for (int ai = 0; ai < 2; ++ai)
#pragma unroll
                    for (int m = 0; m < 4; ++m) acc[ai][bj][m][n] += bv; }
        f32x4 pre[4][2][2];
#pragma unroll
        for (int m = 0; m < 4; ++m) { const size_t off = (size_t)(u.pm * BM + wr * 64 + m * 16 + fr) * ldc + col0;
#pragma unroll
            for (int bj = 0; bj < 2; ++bj)
#pragma unroll
                for (int n = 0; n < 2; ++n) pre[m][bj][n] = *(const f32x4*)(base + off + bj * HALF + n * 16); }
        const bool bad = st.run(acc, u, wr, wc, fr, fq, lds, wid, lane) || poison != 0u;
        const float qnan = __builtin_nanf("");
#pragma unroll
        for (int ai = 0; ai < 2; ++ai)
#pragma unroll
            for (int m = 0; m < 4; ++m) { const int r = ai * HALF + wr * 64 + m * 16 + fr; const f32x2v sr = S[r]; const size_t off = (size_t)(u.pm * BM + r) * ldc + col0;
#pragma unroll
                for (int bj = 0; bj < 2; ++bj)
#pragma unroll
                    for (int n = 0; n < 2; ++n) { const f32x4 bs = ai == 0 ? pre[m][bj][n] : *(const f32x4*)(base + off + bj * HALF + n * 16); f32x4 o = bs + (acc[ai][bj][m][n] - sr.x) * sr.y;
                        if (bad) o = (f32x4){qnan, qnan, qnan, qnan}; *(f32x4*)(out + off + bj * HALF + n * 16) = o; }
                if (m & 1) asm volatile("" ::: "memory"); }
    }
};
struct EpiLnResLn {
    static constexpr bool PERM = false, AFTER_DRAIN = true;
    const float* base; float* out; bf16_t* xn; int ldc; const float* bias; PanelStats st1, st2; unsigned poison;
    __device__ __forceinline__ void fused(f32x4 (&acc)[2][2][4][2], const Unit& u, int wr, int wc, int fr, int fq, PG8_LAS unsigned char* lds, int wid, int lane) const {
        typedef float f32x2v __attribute__((ext_vector_type(2))); typedef unsigned u32x2v __attribute__((ext_vector_type(2)));
        const PG8_LAS f32x2v* S = (const PG8_LAS f32x2v*)(lds + 8192);
        const int col0 = u.pn * BM + wc * 32 + 4 * fq;
#pragma unroll
        for (int bj = 0; bj < 2; ++bj)
#pragma unroll
            for (int n = 0; n < 2; ++n) { const f32x4 bv = bias ? *(const f32x4*)(bias + col0 + bj * HALF + n * 16) : (f32x4){0.f, 0.f, 0.f, 0.f};
#pragma unroll
                for (int ai = 0; ai < 2; ++ai)
#pragma unroll
                    for (int m = 0; m < 4; ++m) acc[ai][bj][m][n] += bv; }
        bool bad = st1.run(acc, u, wr, wc, fr, fq, lds, wid, lane) || poison != 0u;
        const float qnan = __builtin_nanf("");
#pragma unroll
        for (int ai = 0; ai < 2; ++ai)
#pragma unroll
            for (int m = 0; m < 4; ++m) { const int r = ai * HALF + wr * 64 + m * 16 + fr; const f32x2v sr = S[r]; const size_t off = (size_t)(u.pm * BM + r) * ldc + col0;
#pragma unroll
                for (int bj = 0; bj < 2; ++bj)
#pragma unroll
                    for (int n = 0; n < 2; ++n) { const f32x4 bs = *(const f32x4*)(base + off + bj * HALF + n * 16); acc[ai][bj][m][n] = bs + (acc[ai][bj][m][n] - sr.x) * sr.y; }
                asm volatile("" : "+v"(acc[ai][0][m][0]), "+v"(acc[ai][0][m][1]), "+v"(acc[ai][1][m][0]), "+v"(acc[ai][1][m][1]));
                if (m & 1) asm volatile("" ::: "memory"); }
        const bool bad1 = bad;
        bad = st2.run(acc, u, wr, wc, fr, fq, lds, wid, lane) || bad;
#pragma unroll
        for (int ai = 0; ai < 2; ++ai)
#pragma unroll
            for (int m = 0; m < 4; ++m) { const int r = ai * HALF + wr * 64 + m * 16 + fr; const f32x2v sr = S[r]; const size_t off = (size_t)(u.pm * BM + r) * ldc + col0;
#pragma unroll
                for (int bj = 0; bj < 2; ++bj)
#pragma unroll
                    for (int n = 0; n < 2; ++n) { const f32x4 x1 = acc[ai][bj][m][n]; *(f32x4*)(out + off + bj * HALF + n * 16) = bad1 ? (f32x4){qnan, qnan, qnan, qnan} : x1;
                        const f32x4 o = (x1 - sr.x) * sr.y; u32x2v w; w.x = cvt_pk_bf16(o[0], o[1]); w.y = cvt_pk_bf16(o[2], o[3]);
                        if (bad) { w.x = 0x7fc07fc0u; w.y = 0x7fc07fc0u; } *(u32x2v*)(xn + off + bj * HALF + n * 16) = w; }
                asm volatile("" ::: "memory"); }
    }
};

template <class Epi, class Sched, bool ALIGN_EPI = false, bool SP2 = false>
__device__ __forceinline__ void gemm_phase(PG8_LAS unsigned char* lds, const Gemm g, const Sched& S, const Epi& E) {
    const int tid = threadIdx.x, wid = __builtin_amdgcn_readfirstlane(tid >> 6), lane = tid & 63, wr = wid >> 2, wc = wid & 3, fr = lane & 15, fq = lane >> 4;
    const int K = g.K, nt = K / BK;
    unsigned voffA[2], voffB[2];
#pragma unroll
    for (int i = 0; i < 2; ++i) { int R, C; stage_rc(tid * 16 + i * 8192, R, C); const int Rb = Epi::PERM ? ((R & ~31) + perm32(R & 31)) : R;
        voffA[i] = (unsigned)(R * K + C) * 2u; voffB[i] = (unsigned)(Rb * K + C) * 2u; }
    const size_t kstep = (size_t)(BK * 2);
    const size_t hstep = (size_t)HALF * K * 2;
    const size_t tstep = 2 * hstep;
    const unsigned ldsw = (unsigned)wid * 1024u;
    const int aoff = lds_byte(wr * 64 + fr, fq * 8), boff = lds_byte(wc * 32 + fr, fq * 8);
#define PG8_SA(b, h) (((b) * 2 + (h)) * HTB)
#define PG8_SB(b, h) ((4 + (b) * 2 + (h)) * HTB)
#define PG8_STAGE(bufoff, gbase, voff) do { _Pragma("unroll") for (int _i = 0; _i < 2; ++_i) \
        __builtin_amdgcn_global_load_lds((const unsigned*)((const char*)(gbase) + (voff)[_i]), (PG8_LAS unsigned*)(lds + (bufoff) + ldsw + _i * 8192), 16, 0, 0); } while (0)
#define PG8_LDA(dst, b, h) do { _Pragma("unroll") for (int m = 0; m < 4; ++m) _Pragma("unroll") for (int k = 0; k < 2; ++k) dst[m][k] = *(const PG8_LAS bf16x8*)(lds + PG8_SA(b, h) + aoff + m * 2048 + k * 1024); } while (0)
#define PG8_LDB(dst, b, h) do { _Pragma("unroll") for (int n = 0; n < 2; ++n) _Pragma("unroll") for (int k = 0; k < 2; ++k) dst[n][k] = *(const PG8_LAS bf16x8*)(lds + PG8_SB(b, h) + boff + n * 2048 + k * 1024); } while (0)
#define PG8_MMA(ai, bj, At, Bt) do { __builtin_amdgcn_s_setprio(1); _Pragma("unroll") for (int m = 0; m < 4; ++m) _Pragma("unroll") for (int n = 0; n < 2; ++n) _Pragma("unroll") for (int k = 0; k < 2; ++k) \
        acc[ai][bj][m][n] = __builtin_amdgcn_mfma_f32_16x16x32_bf16(Bt[n][k], At[m][k], acc[ai][bj][m][n], 0, 0, 0); __builtin_amdgcn_s_setprio(0); } while (0)
#define PG8_WAIT_V(n) asm volatile("s_waitcnt vmcnt(" #n ")" ::: "memory")
#define PG8_WAIT_L(n) asm volatile("s_waitcnt lgkmcnt(" #n ")" ::: "memory")
#define PG8_BAR __builtin_amdgcn_s_barrier()
#define PG8_SCHED __builtin_amdgcn_sched_barrier(0)
    Unit cur, nxt; int ui = 0;
    if (!S.next(0, cur)) return;
    f32x4 acc[2][2][4][2];
#pragma unroll
    for (int a = 0; a < 2; ++a)
#pragma unroll
        for (int b = 0; b < 2; ++b)
#pragma unroll
            for (int m = 0; m < 4; ++m)
#pragma unroll
                for (int n = 0; n < 2; ++n) acc[a][b][m][n] = (f32x4){0.f, 0.f, 0.f, 0.f};
    bf16x8 At[4][2], B0[2][2], B1[2][2];
    const char* cA = (const char*)g.A + (size_t)cur.pm * tstep; const char* cB = (const char*)g.Bt + (size_t)cur.pn * tstep;
    S.a_ready(cur);
    if constexpr (SP2) {
        PG8_STAGE(PG8_SB(0, 0), cB, voffB); PG8_STAGE(PG8_SB(0, 1), cB + hstep, voffB); PG8_STAGE(PG8_SA(0, 0), cA, voffA); PG8_STAGE(PG8_SA(0, 1), cA + hstep, voffA);
        if (wr == 1) PG8_BAR;
        PG8_WAIT_V(2); PG8_BAR;
        PG8_STAGE(PG8_SB(1, 0), cB + kstep, voffB); PG8_STAGE(PG8_SA(1, 0), cA + kstep, voffA); PG8_STAGE(PG8_SB(1, 1), cB + hstep + kstep, voffB);
        PG8_WAIT_V(6); PG8_BAR;
    } else {
        PG8_STAGE(PG8_SB(0, 0), cB, voffB); PG8_STAGE(PG8_SA(0, 0), cA, voffA); PG8_STAGE(PG8_SB(0, 1), cB + hstep, voffB); PG8_STAGE(PG8_SA(0, 1), cA + hstep, voffA);
        if (wr == 1) PG8_BAR;
        PG8_WAIT_V(4); PG8_BAR;
        PG8_STAGE(PG8_SB(1, 0), cB + kstep, voffB); PG8_STAGE(PG8_SA(1, 0), cA + kstep, voffA); PG8_STAGE(PG8_SB(1, 1), cB + hstep + kstep, voffB);
        PG8_WAIT_V(6); PG8_BAR;
    }
    for (;;) {
        const bool has_next = S.next(ui + 1, nxt);
        const char* nA = has_next ? (const char*)g.A + (size_t)nxt.pm * tstep : cA; const char* nB = has_next ? (const char*)g.Bt + (size_t)nxt.pn * tstep : cB;
        for (int t = 0; t < nt; t += 2) {
            const bool last = (t == nt - 2);
            const char* a1 = cA + (size_t)(t + 1) * kstep;
            const char* a2 = last ? nA : cA + (size_t)(t + 2) * kstep; const char* b2 = last ? nB : cB + (size_t)(t + 2) * kstep;
            const char* a3 = a2 + kstep; const char* b3 = b2 + kstep;
            if (last && has_next) S.a_ready(nxt);
            if constexpr (SP2) {
            PG8_LDB(B0, 0, 0); PG8_LDB(B1, 0, 1); PG8_SCHED; PG8_LDA(At, 0, 0); PG8_STAGE(PG8_SA(1, 1), a1 + hstep, voffA);
            PG8_WAIT_V(8); PG8_WAIT_L(0); PG8_BAR; PG8_MMA(0, 0, At, B0); PG8_MMA(0, 1, At, B1); PG8_BAR; PG8_SCHED;
            PG8_LDA(At, 0, 1); PG8_STAGE(PG8_SB(0, 0), b2, voffB); PG8_STAGE(PG8_SB(0, 1), b2 + hstep, voffB); PG8_STAGE(PG8_SA(0, 0), a2, voffA);
            PG8_WAIT_V(8); PG8_WAIT_L(0); PG8_BAR; PG8_MMA(1, 0, At, B0); PG8_MMA(1, 1, At, B1); PG8_BAR; PG8_SCHED;
            PG8_LDB(B0, 1, 0); PG8_LDB(B1, 1, 1); PG8_SCHED; PG8_LDA(At, 1, 0); PG8_STAGE(PG8_SA(0, 1), a2 + hstep, voffA);
            PG8_WAIT_V(8); PG8_WAIT_L(0); PG8_BAR; PG8_MMA(0, 0, At, B0); PG8_MMA(0, 1, At, B1); PG8_BAR; PG8_SCHED;
            PG8_LDA(At, 1, 1); PG8_STAGE(PG8_SB(1, 0), b3, voffB); PG8_STAGE(PG8_SB(1, 1), b3 + hstep, voffB); PG8_STAGE(PG8_SA(1, 0), a3, voffA);
            PG8_WAIT_V(8); PG8_WAIT_L(0); PG8_BAR; PG8_MMA(1, 0, At, B0); PG8_MMA(1, 1, At, B1); PG8_BAR; PG8_SCHED;
            } else {
            PG8_LDB(B0, 0, 0); PG8_SCHED; PG8_LDA(At, 0, 0); PG8_STAGE(PG8_SA(1, 1), a1 + hstep, voffA);
            PG8_WAIT_L(8); PG8_BAR; PG8_WAIT_L(0); PG8_MMA(0, 0, At, B0); PG8_BAR; PG8_SCHED;
            PG8_LDB(B1, 0, 1); PG8_STAGE(PG8_SB(0, 0), b2, voffB);
            PG8_BAR; PG8_WAIT_L(0); PG8_MMA(0, 1, At, B1); PG8_BAR;
            PG8_LDA(At, 0, 1); PG8_STAGE(PG8_SA(0, 0), a2, voffA);
            PG8_BAR; PG8_WAIT_L(0); PG8_MMA(1, 0, At, B0); PG8_BAR; PG8_SCHED;
            PG8_STAGE(PG8_SB(0, 1), b2 + hstep, voffB);
            PG8_WAIT_V(6); PG8_BAR; PG8_MMA(1, 1, At, B1); PG8_BAR;
            PG8_LDB(B0, 1, 0); PG8_SCHED; PG8_LDA(At, 1, 0); PG8_STAGE(PG8_SA(0, 1), a2 + hstep, voffA);
            PG8_WAIT_L(8); PG8_BAR; PG8_WAIT_L(0); PG8_MMA(0, 0, At, B0); PG8_BAR; PG8_SCHED;
            PG8_LDB(B1, 1, 1); PG8_STAGE(PG8_SB(1, 0), b3, voffB);
            PG8_BAR; PG8_WAIT_L(0); PG8_MMA(0, 1, At, B1); PG8_BAR;
            PG8_LDA(At, 1, 1); PG8_STAGE(PG8_SA(1, 0), a3, voffA);
            PG8_BAR; PG8_WAIT_L(0); PG8_MMA(1, 0, At, B0); PG8_BAR; PG8_SCHED;
            PG8_STAGE(PG8_SB(1, 1), b3 + hstep, voffB);
            PG8_WAIT_V(6); PG8_BAR; PG8_MMA(1, 1, At, B1); PG8_BAR;
            }
        }
        if constexpr (ALIGN_EPI) { if (wr == 0) PG8_BAR; }
        if constexpr (!Epi::AFTER_DRAIN) { E(acc, cur, wr, wc, fr, fq); S.done(cur); }
        if (!has_next) break;
#pragma unroll
        for (int a = 0; a < 2; ++a)
#pragma unroll
            for (int b = 0; b < 2; ++b)
#pragma unroll
                for (int m = 0; m < 4; ++m)
#pragma unroll
                    for (int n = 0; n < 2; ++n) acc[a][b][m][n] = (f32x4){0.f, 0.f, 0.f, 0.f};
        cur = nxt; cA = nA; cB = nB; ++ui;
        if constexpr (ALIGN_EPI) { if (wr == 1) PG8_BAR; }
    }
    PG8_WAIT_V(0);
    if constexpr (!ALIGN_EPI) { if (wr == 0) PG8_BAR; }
    PG8_BAR;
    if constexpr (Epi::AFTER_DRAIN) { E.fused(acc, cur, wr, wc, fr, fq, lds, wid, lane); S.done(cur); }
#undef PG8_SA
#undef PG8_SB
#undef PG8_STAGE
#undef PG8_LDA
#undef PG8_LDB
#undef PG8_MMA
#undef PG8_WAIT_V
#undef PG8_WAIT_L
#undef PG8_BAR
#undef PG8_SCHED
}
}
#ifndef PG8_SP2
#define PG8_SP2 true
#endif
#ifndef PG8_ALIGN
#define PG8_ALIGN true
#endif
#define GAS __attribute__((address_space(1)))
#define LAS __attribute__((address_space(3)))
typedef unsigned short bf16;
typedef unsigned v4u __attribute__((ext_vector_type(4)));
typedef float f32x4 __attribute__((ext_vector_type(4)));
typedef short bf16x8 __attribute__((ext_vector_type(8)));
typedef GAS unsigned gu32;
typedef GAS unsigned long long gu64;
#define RLX_AGENT __ATOMIC_RELAXED, __HIP_MEMORY_SCOPE_AGENT
#define LDS_WAIT() asm volatile("s_waitcnt lgkmcnt(0)" ::: "memory")
#define VM_WAIT() asm volatile("s_waitcnt vmcnt(0)" ::: "memory")
__device__ __forceinline__ unsigned long long rt() { return __builtin_amdgcn_s_memrealtime(); }
__device__ __forceinline__ unsigned f2bf(float f) { unsigned u = __builtin_bit_cast(unsigned, f); return (u + 0x7fffu + ((u >> 16) & 1u)) >> 16; }
__device__ __forceinline__ unsigned pk2(float lo, float hi) { return f2bf(lo) | (f2bf(hi) << 16); }

#define XB_TMO      128
#define XB_XCNT(j)  (256  + 64 * (j))
#define XB_XSUB(j)  (1280 + 64 * (j))
#define XB_XGEN(j)  (2304 + 64 * (j))
#define XB_TOP      3328
#define XB_TOPGEN   3392
#define XCD_BAR_WORDS 3456
#define XB_SPIN_CAP (1u << 18)

__device__ __forceinline__ unsigned xb_ld(unsigned* p)              { return __hip_atomic_load(p, __ATOMIC_RELAXED, __HIP_MEMORY_SCOPE_AGENT); }
__device__ __forceinline__ unsigned xb_add(unsigned* p, unsigned v) { return __hip_atomic_fetch_add(p, v, __ATOMIC_RELAXED, __HIP_MEMORY_SCOPE_AGENT); }
__device__ __forceinline__ unsigned xb_xcc_id() { return (unsigned)__builtin_amdgcn_s_getreg((3 << 11) | 20) & 0xFu; }
#define XB_SPIN(cond, bar) do { unsigned _sp = 0; while (cond) { __builtin_amdgcn_s_sleep(1); \
    if ((++_sp & 255u) == 0u) { if (xb_ld(&(bar)[XB_TMO])) break; if (_sp > XB_SPIN_CAP) { atomicAdd(&(bar)[XB_TMO], 1u); break; } } } } while (0)

struct XcdBarrier {
    unsigned* bar; unsigned x;
    volatile LAS unsigned* st;
};

__device__ __forceinline__ XcdBarrier xcd_barrier_post(unsigned* bar, volatile LAS unsigned* st) {
    XcdBarrier b; b.bar = bar; b.x = xb_xcc_id(); b.st = st;
    if (threadIdx.x == 0) (void)xb_add(&bar[XB_XCNT(b.x)], 1u);
    return b;
}
__device__ __forceinline__ void xcd_barrier_complete(unsigned* bar, unsigned x, unsigned& nloc, unsigned& nx) {
    const unsigned G = gridDim.x * gridDim.y * gridDim.z;
    unsigned sum, cnt, mine, sp = 0u;
    for (;;) {
        sum = 0u; cnt = 0u; mine = 0u;
#pragma unroll
        for (unsigned j = 0; j < 16; ++j) { const unsigned c = xb_ld(&bar[XB_XCNT(j)]); sum += c; cnt += (c > 0u) ? 1u : 0u; mine = (j == x) ? c : mine; }
        if (sum == G) break;
        __builtin_amdgcn_s_sleep(1);
        if ((++sp & 255u) == 0u) { if (xb_ld(&bar[XB_TMO])) break; if (sp > XB_SPIN_CAP) { atomicAdd(&bar[XB_TMO], 1u); break; } }
    }
    nloc = mine > 0u ? mine : 1u; nx = cnt > 0u ? cnt : 1u;
}

__device__ __forceinline__ void xcd_barrier(const XcdBarrier& b) {
    asm volatile("s_waitcnt vmcnt(0)" ::: "memory");
    __syncthreads();
    if (threadIdx.x == 0) {
        unsigned* bar = b.bar;
        __builtin_amdgcn_s_waitcnt(0);
        unsigned nloc = b.st[0], nx = b.st[1];
        if (nloc == 0u) { xcd_barrier_complete(bar, b.x, nloc, nx); b.st[0] = nloc; b.st[1] = nx; }
        const unsigned old = xb_add(&bar[XB_XSUB(b.x)], 1u);
        const unsigned gen = old / nloc;
        if (old + 1u == (gen + 1u) * nloc) {
            __builtin_amdgcn_fence(__ATOMIC_RELEASE, "agent");
            asm volatile("s_waitcnt vmcnt(0)" ::: "memory");
            const unsigned og = xb_add(&bar[XB_TOP], 1u);
            const unsigned tg = og / nx;
            if (og + 1u == (tg + 1u) * nx) xb_add(&bar[XB_TOPGEN], 1u);
            else XB_SPIN(xb_ld(&bar[XB_TOPGEN]) == tg, bar);
            __builtin_amdgcn_fence(__ATOMIC_ACQUIRE, "agent");
            xb_add(&bar[XB_XGEN(b.x)], 1u);
            asm volatile("s_waitcnt vmcnt(0)" ::: "memory");
        } else {
            XB_SPIN(xb_ld(&bar[XB_XGEN(b.x)]) == gen, bar);
            __builtin_amdgcn_fence(__ATOMIC_ACQUIRE, "agent");
            asm volatile("s_waitcnt vmcnt(0)" ::: "memory");
        }
    }
    __syncthreads();
}
constexpr int NWAVES = 8, NTHREADS = 512;
constexpr int DM = 1024, SEQ = 8192, MP = 16384, NS = 128, MT = 16640;
constexpr int FF = 2816, FF2 = 5632, NMOD = 14336, NIN = 3072, LDW_IN = 3080;
constexpr int QW = 1536;
constexpr float EPSN = 1e-6f;
constexpr float LOG2E = 1.4426950408889634f;
constexpr float ATT_C2 = 0.10206207261596577f * 1.4426950408889634f;
constexpr float QK_SCALE = 0.08838834764831845f;
constexpr size_t O_YP = 0, O_YS = 16777216, O_CP = 16908288, O_NP = 17170432, O_MP = 17171456, O_CONVP = 17171464, O_CKVP = 17193992, O_KPEP = 21388296,
                 O_CS = 21912584, O_NS = 38689800, O_MS = 38755336, O_CONVS = 38755848, O_CKVS = 40197640, O_KPES = 40230408, O_END = 40234504;

constexpr size_t al256(size_t x) { return (x + 255) & ~(size_t)255; }
constexpr size_t WS_CTL = 0, CTL_ZERO_BYTES = 1u << 20;
constexpr size_t WS_WIN   = WS_CTL + CTL_ZERO_BYTES;
constexpr size_t WS_WOUT  = WS_WIN + (size_t)NIN * DM * 2;
constexpr size_t WS_WUP   = WS_WOUT + (size_t)DM * DM * 2;
constexpr size_t WS_WDOWN = WS_WUP + 2 * (size_t)FF2 * DM * 2;
constexpr size_t WS_WDKV  = WS_WDOWN + 2 * (size_t)DM * FF * 2;
constexpr size_t WS_WDQ   = WS_WDKV + (size_t)512 * DM * 2;
constexpr size_t WS_WUQ   = WS_WDQ + (size_t)512 * DM * 2;
constexpr size_t WS_WKV   = WS_WUQ + (size_t)QW * 384 * 2;
constexpr size_t WS_WO    = WS_WKV + (size_t)2048 * 256 * 2;
constexpr size_t WS_WMOD  = WS_WO + (size_t)DM * DM * 2;
constexpr size_t WS_AMOD  = WS_WMOD + (size_t)NMOD * DM * 2;
constexpr size_t WS_MOD   = WS_AMOD + (size_t)256 * DM * 2;
constexpr size_t WS_ROPE  = WS_MOD + (size_t)256 * NMOD * 4;
constexpr size_t WS_X     = al256(WS_ROPE + (size_t)8193 * 32 * 4);
constexpr size_t WS_XN    = WS_X + (size_t)MT * DM * 4;
constexpr size_t WS_XN2   = WS_XN + (size_t)MT * DM * 2;
constexpr size_t WS_QKVO  = WS_XN2 + (size_t)MT * DM * 2;
constexpr size_t WS_GATES = WS_QKVO + (size_t)MT * NIN * 2;
constexpr size_t WS_CT    = al256(WS_GATES + (size_t)MT * 8 * 4);
constexpr size_t WS_NL    = WS_CT + (size_t)8 * 128 * 256 * 128 * 2;
constexpr size_t WS_CHK   = WS_NL + (size_t)8 * 128 * 128 * 4;
constexpr size_t WS_AG    = al256(WS_CHK + 3 * 1024 * 4);
constexpr size_t WS_U     = WS_AG + (size_t)MT * FF2 * 2;
constexpr size_t WS_LAT   = WS_U + (size_t)MT * FF * 2;
constexpr size_t WS_QLAT  = WS_LAT + (size_t)MT * 512 * 4;
constexpr size_t WS_CKV   = WS_QLAT + (size_t)MT * 512 * 4;
constexpr size_t WS_KPE   = WS_CKV + (size_t)MT * 256 * 2;
constexpr size_t WS_QN    = WS_KPE + (size_t)MT * 32 * 2;
constexpr size_t WS_Q     = WS_QN + (size_t)MT * 384 * 2;
constexpr size_t WS_KN    = WS_Q + (size_t)MT * QW * 2;
constexpr size_t WS_V     = WS_KN + (size_t)MT * DM * 2;
constexpr size_t WS_PART  = WS_V + (size_t)MT * DM * 2;
constexpr size_t WS_QLS   = WS_PART + (size_t)256 * (4096 + 32) * 4;
constexpr size_t WS_END   = al256(WS_QLS + (size_t)128 * 16 * 288 * 2);
constexpr int CW_BAR = 4096;

constexpr int RING_OFF = 0, RING_BYTES = 131072;
constexpr int LDSCTL_OFF = RING_BYTES, MISC_OFF = LDSCTL_OFF + 320;
constexpr int LDS_BYTES = 147456;

struct Params {
    const float *x_p, *x_s, *st_C, *st_n, *st_m, *st_conv, *cache_ckv, *cache_kpe; const int* page_table;
    const float *c_p, *c_s, *g_norm1, *g_norm2, *w_ada, *b_ada, *w_up, *w_conv, *b_conv, *w_down, *w_m_in, *b_m_gates, *g_m_head, *w_m_out,
                *g_kv_in, *w_ada_kv, *b_ada_kv, *w_dkv, *g_kv, *w_uk, *w_uv, *w_dq, *g_q, *w_uq, *w_o, *g_final;
    float* out; unsigned char* ws; int ph_lo, ph_hi;
};

typedef unsigned u32x2 __attribute__((ext_vector_type(2)));
typedef float f32x2 __attribute__((ext_vector_type(2)));
typedef short s16x4 __attribute__((ext_vector_type(4)));
typedef float f32x16 __attribute__((ext_vector_type(16)));
typedef __bf16 bf16x2_t __attribute__((ext_vector_type(2)));

__device__ __forceinline__ unsigned cvtpk(float lo, float hi) { f32x2 v = {lo, hi}; bf16x2_t b = __builtin_convertvector(v, bf16x2_t); return __builtin_bit_cast(unsigned, b); }
__device__ __forceinline__ float bf_lo(unsigned u) { return __uint_as_float(u << 16); }
__device__ __forceinline__ float bf_hi(unsigned u) { return __uint_as_float(u & 0xffff0000u); }
__device__ __forceinline__ float bf2f(bf16 b) { return __uint_as_float((unsigned)b << 16); }
__device__ __forceinline__ float wave_sum(float v) {
#pragma unroll
    for (int o = 1; o < 64; o <<= 1) v += __shfl_xor(v, o);
    return v;
}
__device__ __forceinline__ float wave_max(float v) {
#pragma unroll
    for (int o = 1; o < 64; o <<= 1) v = fmaxf(v, __shfl_xor(v, o));
    return v;
}
__device__ __forceinline__ float wave_scan_add(float v, int lane) {
#pragma unroll
    for (int o = 1; o < 64; o <<= 1) { const float t = __shfl_up(v, o); if (lane >= o) v += t; }
    return v;
}
__device__ __forceinline__ float wave_scan_max(float v, int lane) {
#pragma unroll
    for (int o = 1; o < 64; o <<= 1) { const float t = __shfl_up(v, o); if (lane >= o) v = fmaxf(v, t); }
    return v;
}
__device__ __forceinline__ float sigmoidf_(float x) { return 1.0f / (1.0f + __expf(-x)); }
__device__ __forceinline__ float siluf_(float x) { return x / (1.0f + __expf(-x)); }
__device__ __forceinline__ float log_sigmoidf_(float x) { return x >= 0.f ? -log1pf(__expf(-x)) : x - log1pf(__expf(x)); }
__device__ __forceinline__ int mrow_of(int r) { return r < MP ? 128 + (r >> 13) : (r < MP + NS ? r - MP : 255); }
__device__ __forceinline__ int pos_of(int r) { return r < MP ? (r & (SEQ - 1)) : SEQ; }

struct Ctx {
    LAS unsigned char* lds; int tid, lane, wave, vcu, G, gw, NGW;
};

struct EpiMod {
    static constexpr bool PERM = false, AFTER_DRAIN = false;
    float* O; const float* b_ada; const float* b_kv;
    __device__ __forceinline__ void operator()(const pg8::f32x4 (&acc)[2][2][4][2], const pg8::Unit& u, int wr, int wc, int fr, int fq) const {
        const int row0 = u.pm * 256 + wr * 64 + fr, col0 = u.pn * 256 + wc * 32 + 4 * fq;
        const float* bp = (u.pn * 256 < 12288) ? b_ada : (b_kv - 12288);
#pragma unroll
        for (int bj = 0; bj < 2; ++bj)
#pragma unroll
            for (int n = 0; n < 2; ++n) { const int col = col0 + bj * 128 + n * 16; const pg8::f32x4 bv = *(const pg8::f32x4*)(bp + col);
#pragma unroll
                for (int ai = 0; ai < 2; ++ai)
#pragma unroll
                    for (int m = 0; m < 4; ++m) { const int row = row0 + ai * 128 + m * 16; *(pg8::f32x4*)(O + (size_t)row * NMOD + col) = acc[ai][bj][m][n] + bv; } }
    }
};
struct EpiF32 {
    static constexpr bool PERM = false, AFTER_DRAIN = false;
    float* O; int ldc;
    __device__ __forceinline__ void operator()(const pg8::f32x4 (&acc)[2][2][4][2], const pg8::Unit& u, int wr, int wc, int fr, int fq) const {
        const int row0 = u.pm * 256 + wr * 64 + fr, col0 = u.pn * 256 + wc * 32 + 4 * fq;
#pragma unroll
        for (int ai = 0; ai < 2; ++ai)
#pragma unroll
            for (int m = 0; m < 4; ++m) { const int row = row0 + ai * 128 + m * 16;
#pragma unroll
                for (int bj = 0; bj < 2; ++bj)
#pragma unroll
                    for (int n = 0; n < 2; ++n) *(pg8::f32x4*)(O + (size_t)row * ldc + col0 + bj * 128 + n * 16) = acc[ai][bj][m][n]; }
    }
};
struct EpiRes {
    static constexpr bool PERM = false, AFTER_DRAIN = false;
    float* X; const float* gate;
    __device__ __forceinline__ void operator()(const pg8::f32x4 (&acc)[2][2][4][2], const pg8::Unit& u, int wr, int wc, int fr, int fq) const {
        const int row0 = u.pm * 256 + wr * 64 + fr, col0 = u.pn * 256 + wc * 32 + 4 * fq;
#pragma unroll
        for (int ai = 0; ai < 2; ++ai)
#pragma unroll
            for (int m = 0; m < 4; ++m) { const int row = row0 + ai * 128 + m * 16; const float* gp = gate + (size_t)mrow_of(row) * NMOD; float* xp = X + (size_t)row * DM;
#pragma unroll
                for (int bj = 0; bj < 2; ++bj)
#pragma unroll
                    for (int n = 0; n < 2; ++n) { const int col = col0 + bj * 128 + n * 16; const pg8::f32x4 gv = *(const pg8::f32x4*)(gp + col); const pg8::f32x4 xv = *(const pg8::f32x4*)(xp + col);
                        *(pg8::f32x4*)(xp + col) = xv + gv * acc[ai][bj][m][n]; }
                if (m & 1) asm volatile("" ::: "memory"); }
    }
};
struct EpiRope {
    static constexpr bool PERM = false, AFTER_DRAIN = false;
    bf16* Q; const float* tab;
    __device__ __forceinline__ void operator()(const pg8::f32x4 (&acc)[2][2][4][2], const pg8::Unit& u, int wr, int wc, int fr, int fq) const {
        const int row0 = u.pm * 256 + wr * 64 + fr, col0 = u.pn * 256 + wc * 32 + 4 * fq;
#pragma unroll
        for (int ai = 0; ai < 2; ++ai)
#pragma unroll
            for (int m = 0; m < 4; ++m) { const int row = row0 + ai * 128 + m * 16; const int pos = pos_of(row);
#pragma unroll
                for (int bj = 0; bj < 2; ++bj) { const int g = 8 * u.pn + 4 * bj + wc; pg8::f32x4 x1 = acc[ai][bj][m][0], x2 = acc[ai][bj][m][1];
                    if (g % 3 == 2) { const pg8::f32x4 c = *(const pg8::f32x4*)(tab + pos * 16 + 4 * fq), s = *(const pg8::f32x4*)(tab + 8193 * 16 + pos * 16 + 4 * fq);
                        const pg8::f32x4 o1 = x1 * c - x2 * s, o2 = x1 * s + x2 * c; x1 = o1; x2 = o2; }
                    bf16* qp = Q + (size_t)row * QW + col0 + bj * 128;
                    u32x2 w1; w1.x = cvtpk(x1[0], x1[1]); w1.y = cvtpk(x1[2], x1[3]); *(u32x2*)qp = w1;
                    u32x2 w2; w2.x = cvtpk(x2[0], x2[1]); w2.y = cvtpk(x2[2], x2[3]); *(u32x2*)(qp + 16) = w2; }
                asm volatile("" ::: "memory"); }
    }
};
__device__ __forceinline__ void tr_item(const float* W, int ldw, int nblk, int K, bf16* WT, int row_off, float scale, LAS float* scr, int item, int lane) {
    const int kb = item / nblk, nb = item % nblk, k0 = 64 * kb, n0 = 32 * nb;
#pragma unroll 8
    for (int i = 0; i < 32; ++i) { const int kk = 2 * i + (lane >> 5); scr[kk * 33 + (lane & 31)] = W[(size_t)(k0 + kk) * ldw + n0 + (lane & 31)] * scale; }
    LDS_WAIT(); asm volatile("" ::: "memory");
    const int c = lane & 7;
#pragma unroll
    for (int j = 0; j < 4; ++j) { const int n = (lane >> 3) + 8 * j; const LAS float* s = scr + (8 * c) * 33 + n;
        v4u o; o.x = cvtpk(s[0 * 33], s[1 * 33]); o.y = cvtpk(s[2 * 33], s[3 * 33]); o.z = cvtpk(s[4 * 33], s[5 * 33]); o.w = cvtpk(s[6 * 33], s[7 * 33]);
        *(GAS v4u*)(WT + (size_t)(row_off + n0 + n) * K + k0 + 8 * c) = o; }
    LDS_WAIT(); asm volatile("" ::: "memory");
}
__device__ __forceinline__ void p0_prologue(const Params& P, const Ctx& C) {
    unsigned char* ws = P.ws;
    LAS float* scr = (LAS float*)(C.lds + RING_OFF + C.wave * 16384);
    constexpr int I_IN = 16 * 96, I_OUT = 16 * 32, I_UP = 16 * 176, I_DOWN = 44 * 32, I_DKV = 16 * 9, I_DQ = 16 * 12, I_UQ = 6 * 48, I_UK = 4 * 32, I_O = 16 * 32, I_ADA = 16 * 192, I_ADAKV = 16 * 64;
    constexpr int NITEMS = I_IN + I_OUT + 2 * I_UP + 2 * I_DOWN + I_DKV + I_DQ + I_UQ + 2 * I_UK + I_O + 2 * I_ADA + I_ADAKV;
    for (int it = C.gw; it < NITEMS; it += C.NGW) {
        int r = it;
        if (r < I_IN) { const int nb = r % 96; tr_item(P.w_m_in, LDW_IN, 96, DM, (bf16*)(ws + WS_WIN), 0, nb < 16 ? QK_SCALE : 1.f, scr, r, C.lane); continue; } r -= I_IN;
        if (r < I_OUT) { tr_item(P.w_m_out, DM, 32, DM, (bf16*)(ws + WS_WOUT), 0, 1.f, scr, r, C.lane); continue; } r -= I_OUT;
        if (r < 2 * I_UP) { const int l = r / I_UP; tr_item(P.w_up + (size_t)l * DM * FF2, FF2, 176, DM, (bf16*)(ws + WS_WUP) + (size_t)l * FF2 * DM, 0, 1.f, scr, r % I_UP, C.lane); continue; } r -= 2 * I_UP;
        if (r < 2 * I_DOWN) { const int l = r / I_DOWN; tr_item(P.w_down + (size_t)l * FF * DM, DM, 32, FF, (bf16*)(ws + WS_WDOWN) + (size_t)l * DM * FF, 0, 1.f, scr, r % I_DOWN, C.lane); continue; } r -= 2 * I_DOWN;
        if (r < I_DKV) { tr_item(P.w_dkv, 288, 9, DM, (bf16*)(ws + WS_WDKV), 0, 1.f, scr, r, C.lane); continue; } r -= I_DKV;
        if (r < I_DQ) { tr_item(P.w_dq, 384, 12, DM, (bf16*)(ws + WS_WDQ), 0, 1.f, scr, r, C.lane); continue; } r -= I_DQ;
        if (r < I_UQ) { tr_item(P.w_uq, QW, 48, 384, (bf16*)(ws + WS_WUQ), 0, ATT_C2, scr, r, C.lane); continue; } r -= I_UQ;
        if (r < I_UK) { tr_item(P.w_uk, DM, 32, 256, (bf16*)(ws + WS_WKV), 0, 1.f, scr, r, C.lane); continue; } r -= I_UK;
        if (r < I_UK) { tr_item(P.w_uv, DM, 32, 256, (bf16*)(ws + WS_WKV), 1024, 1.f, scr, r, C.lane); continue; } r -= I_UK;
        if (r < I_O) { tr_item(P.w_o, DM, 32, DM, (bf16*)(ws + WS_WO), 0, 1.f, scr, r, C.lane); continue; } r -= I_O;
        if (r < 2 * I_ADA) { const int l = r / I_ADA; tr_item(P.w_ada + (size_t)l * DM * 6144, 6144, 192, DM, (bf16*)(ws + WS_WMOD), l * 6144, 1.f, scr, r % I_ADA, C.lane); continue; } r -= 2 * I_ADA;
        tr_item(P.w_ada_kv, 2048, 64, DM, (bf16*)(ws + WS_WMOD), 12288, 1.f, scr, r, C.lane);
    }
    const int gt = C.vcu * NTHREADS + C.tid, NGT = C.G * NTHREADS;
    { v4u z = {0u, 0u, 0u, 0u};
      GAS v4u* a = (GAS v4u*)((bf16*)(ws + WS_WDKV) + (size_t)288 * DM); const int na = (512 - 288) * DM / 8;
      for (int i = gt; i < na; i += NGT) a[i] = z;
      GAS v4u* b = (GAS v4u*)((bf16*)(ws + WS_WDQ) + (size_t)384 * DM); const int nb = (512 - 384) * DM / 8;
      for (int i = gt; i < nb; i += NGT) b[i] = z; }
    { bf16* am = (bf16*)(ws + WS_AMOD);
      for (int i = gt; i < 256 * DM / 4; i += NGT) { const int row = i / (DM / 4), c4 = (i % (DM / 4)) * 4;
          f32x4 v = {0.f, 0.f, 0.f, 0.f};
          if (row < NS) v = *(const f32x4*)(P.c_s + (size_t)row * DM + c4); else if (row < NS + 2) v = *(const f32x4*)(P.c_p + (size_t)(row - NS) * DM + c4);
          u32x2 w; w.x = cvtpk(siluf_(v[0]), siluf_(v[1])); w.y = cvtpk(siluf_(v[2]), siluf_(v[3])); *(u32x2*)(am + (size_t)row * DM + c4) = w; } }
    { float* tab = (float*)(ws + WS_ROPE);
      for (int i = gt; i < 8193 * 16; i += NGT) { const int pos = i >> 4, k = i & 15;
          const double fr = exp2(-(double)k * (13.287712379549449 / 16.0)) * 0.15915494309189535;
          double t = (double)pos * fr; t -= floor(t); const float tf = (float)t;
          tab[i] = __builtin_amdgcn_cosf(tf); tab[8193 * 16 + i] = __builtin_amdgcn_sinf(tf); } }
}

__device__ __forceinline__ void load_row(const float* xr, int lane, f32x4 (&v)[4]) {
#pragma unroll
    for (int j = 0; j < 4; ++j) v[j] = *(const f32x4*)(xr + 4 * lane + 256 * j);
}
__device__ __forceinline__ float row_rstd(const f32x4 (&v)[4]) {
    float s = 0.f;
#pragma unroll
    for (int j = 0; j < 4; ++j) s += (v[j][0] * v[j][0] + v[j][1] * v[j][1]) + (v[j][2] * v[j][2] + v[j][3] * v[j][3]);
    return rsqrtf(wave_sum(s) * (1.f / DM) + EPSN);
}
__device__ __forceinline__ void mod_row(const f32x4 (&v)[4], float rstd, const float* g, const float* sc, const float* sh, int lane, f32x4 (&y)[4]) {
#pragma unroll
    for (int j = 0; j < 4; ++j) { const int c = 4 * lane + 256 * j; const f32x4 gv = *(const f32x4*)(g + c), scv = *(const f32x4*)(sc + c), shv = *(const f32x4*)(sh + c);
        y[j] = (v[j] * rstd) * gv * (scv + 1.0f) + shv; }
}
__device__ __forceinline__ void store_row_bf16(bf16* o, int lane, const f32x4 (&y)[4]) {
#pragma unroll
    for (int j = 0; j < 4; ++j) { u32x2 w; w.x = cvtpk(y[j][0], y[j][1]); w.y = cvtpk(y[j][2], y[j][3]); *(u32x2*)(o + 4 * lane + 256 * j) = w; }
}

__device__ __forceinline__ void p2_norm_in(const Params& P, const Ctx& C) {
    unsigned char* ws = P.ws; const float* MOD = (const float*)(ws + WS_MOD); float* X = (float*)(ws + WS_X); bf16* XN = (bf16*)(ws + WS_XN); float* GT = (float*)(ws + WS_GATES);
    f32x4 wg[4][4][2];
#pragma unroll
    for (int j = 0; j < 4; ++j)
#pragma unroll
        for (int e = 0; e < 4; ++e) { const int k = 4 * C.lane + 256 * j + e; wg[j][e][0] = *(const f32x4*)(P.w_m_in + (size_t)k * LDW_IN + NIN); wg[j][e][1] = *(const f32x4*)(P.w_m_in + (size_t)k * LDW_IN + NIN + 4); }
    for (int r = C.gw; r < MT; r += C.NGW) {
        f32x4 v[4];
        if (r < MP) load_row(P.x_p + (size_t)r * DM, C.lane, v); else if (r < MP + NS) load_row(P.x_s + (size_t)(r - MP) * DM, C.lane, v);
        else { for (int j = 0; j < 4; ++j) v[j] = (f32x4){0.f, 0.f, 0.f, 0.f}; }
#pragma unroll
        for (int j = 0; j < 4; ++j) *(f32x4*)(X + (size_t)r * DM + 4 * C.lane + 256 * j) = v[j];
        const float rstd = row_rstd(v); const float* mr = MOD + (size_t)mrow_of(r) * NMOD;
        f32x4 y[4]; mod_row(v, rstd, P.g_norm1, mr + 1024, mr, C.lane, y);
        store_row_bf16(XN + (size_t)r * DM, C.lane, y);
        f32x4 g0 = {0.f, 0.f, 0.f, 0.f}, g1 = {0.f, 0.f, 0.f, 0.f};
#pragma unroll
        for (int j = 0; j < 4; ++j)
#pragma unroll
            for (int e = 0; e < 4; ++e) { g0 += wg[j][e][0] * y[j][e]; g1 += wg[j][e][1] * y[j][e]; }
#pragma unroll
        for (int q = 0; q < 4; ++q) { g0[q] = wave_sum(g0[q]); g1[q] = wave_sum(g1[q]); }
        if (C.lane == 0) { const f32x4 b0 = *(const f32x4*)(P.b_m_gates), b1 = *(const f32x4*)(P.b_m_gates + 4);
            g0 += b0; g1 += b1; f32x4 lf; lf[0] = log_sigmoidf_(g1[0]); lf[1] = log_sigmoidf_(g1[1]); lf[2] = log_sigmoidf_(g1[2]); lf[3] = log_sigmoidf_(g1[3]);
            *(f32x4*)(GT + (size_t)r * 8) = g0; *(f32x4*)(GT + (size_t)r * 8 + 4) = lf; }
    }
}
__device__ __forceinline__ void norm_rows(const Params& P, const Ctx& C, const float* g, int sc_off, int sh_off, bf16* dst, const float* g2, int sc2_off, int sh2_off, bf16* dst2) {
    unsigned char* ws = P.ws; const float* MOD = (const float*)(ws + WS_MOD); const float* X = (const float*)(ws + WS_X);
    for (int r = C.gw; r < MT; r += C.NGW) {
        f32x4 v[4]; load_row(X + (size_t)r * DM, C.lane, v);
        const float rstd = row_rstd(v); const float* mr = MOD + (size_t)mrow_of(r) * NMOD;
        f32x4 y[4]; mod_row(v, rstd, g, mr + sc_off, mr + sh_off, C.lane, y); store_row_bf16(dst + (size_t)r * DM, C.lane, y);
        if (dst2) { mod_row(v, rstd, g2, mr + sc2_off, mr + sh2_off, C.lane, y); store_row_bf16(dst2 + (size_t)r * DM, C.lane, y); }
    }
}
__device__ __forceinline__ void final_norm(const Params& P, const Ctx& C) {
    const float* X = (const float*)(P.ws + WS_X);
    for (int r = C.gw; r < MP + NS; r += C.NGW) {
        f32x4 v[4]; load_row(X + (size_t)r * DM, C.lane, v); const float rstd = row_rstd(v);
        float* o = P.out + (r < MP ? O_YP + (size_t)r * DM : O_YS + (size_t)(r - MP) * DM);
#pragma unroll
        for (int j = 0; j < 4; ++j) { const int c = 4 * C.lane + 256 * j; *(f32x4*)(o + c) = (v[j] * rstd) * *(const f32x4*)(P.g_final + c); }
    }
}
__device__ __forceinline__ void latent_rows(const Params& P, const Ctx& C) {
    unsigned char* ws = P.ws; const float* LAT = (const float*)(ws + WS_LAT); const float* QLAT = (const float*)(ws + WS_QLAT); const float* tab = (const float*)(ws + WS_ROPE);
    bf16* CKV = (bf16*)(ws + WS_CKV); bf16* KPE = (bf16*)(ws + WS_KPE); bf16* QN = (bf16*)(ws + WS_QN);
    for (int r = C.gw; r < MT; r += C.NGW) {
        const float* lr = LAT + (size_t)r * 512; const int lane = C.lane;
        const f32x4 v = *(const f32x4*)(lr + 4 * lane);
        const float ss = wave_sum((v[0] * v[0] + v[1] * v[1]) + (v[2] * v[2] + v[3] * v[3])); const float rstd = rsqrtf(ss * (1.f / 256.f) + EPSN);
        const f32x4 o = (v * rstd) * *(const f32x4*)(P.g_kv + 4 * lane);
        { u32x2 w; w.x = cvtpk(o[0], o[1]); w.y = cvtpk(o[2], o[3]); *(u32x2*)(CKV + (size_t)r * 256 + 4 * lane) = w; }
        float* ock = nullptr; float* okp = nullptr;
        if (r < MP) { ock = P.out + O_CKVP + (size_t)r * 256; okp = P.out + O_KPEP + (size_t)r * 32; }
        else if (r < MP + NS) { ock = P.out + O_CKVS + (size_t)(r - MP) * 256; okp = P.out + O_KPES + (size_t)(r - MP) * 32; }
        if (ock) *(f32x4*)(ock + 4 * lane) = o;
        { const int pos = pos_of(r); const int i = lane & 15; const float x1 = lr[256 + i], x2 = lr[272 + i]; const float c = tab[pos * 16 + i], s = tab[8193 * 16 + pos * 16 + i];
          const float o1 = x1 * c - x2 * s, o2 = x1 * s + x2 * c;
          if (lane < 16) { KPE[(size_t)r * 32 + i] = (bf16)(cvtpk(o1, 0.f) & 0xffffu); KPE[(size_t)r * 32 + 16 + i] = (bf16)(cvtpk(o2, 0.f) & 0xffffu); if (okp) { okp[i] = o1; okp[16 + i] = o2; } } }
        { const float* qr = QLAT + (size_t)r * 512; f32x2 q[3]; float s = 0.f;
#pragma unroll
          for (int j = 0; j < 3; ++j) { q[j] = *(const f32x2*)(qr + 2 * lane + 128 * j); s += q[j][0] * q[j][0] + q[j][1] * q[j][1]; }
          const float rq = rsqrtf(wave_sum(s) * (1.f / 384.f) + EPSN);
#pragma unroll
          for (int j = 0; j < 3; ++j) { const f32x2 g = *(const f32x2*)(P.g_q + 2 * lane + 128 * j); *(unsigned*)(QN + (size_t)r * 384 + 2 * lane + 128 * j) = cvtpk(q[j][0] * rq * g[0], q[j][1] * rq * g[1]); } }
    }
}
__device__ __forceinline__ void conv_phase(const Params& P, const Ctx& C, int layer) {
    unsigned char* ws = P.ws; const bf16* AG = (const bf16*)(ws + WS_AG); bf16* U = (bf16*)(ws + WS_U);
    const float* wc = P.w_conv + (size_t)layer * 3 * FF; const float* bc = P.b_conv + (size_t)layer * FF;
    const int gt = C.vcu * NTHREADS + C.tid, NGT = C.G * NTHREADS;
    constexpr int NCH = FF / 8, RB = 32, NRB = MP / RB;
    for (int it = gt; it < NRB * NCH; it += NGT) {
        const int rb = it / NCH, ch = it % NCH, c0 = ch * 8, r0 = rb * RB;
        float w0[8], w1[8], w2[8], bb[8];
#pragma unroll
        for (int q = 0; q < 2; ++q) { const f32x4 a = *(const f32x4*)(wc + c0 + 4 * q), b = *(const f32x4*)(wc + FF + c0 + 4 * q), c = *(const f32x4*)(wc + 2 * FF + c0 + 4 * q), d = *(const f32x4*)(bc + c0 + 4 * q);
#pragma unroll
            for (int e = 0; e < 4; ++e) { w0[4 * q + e] = a[e]; w1[4 * q + e] = b[e]; w2[4 * q + e] = c[e]; bb[4 * q + e] = d[e]; } }
        float p2[8], p1[8];
        const bool first = (r0 & (SEQ - 1)) == 0;
        { v4u t2 = {0u, 0u, 0u, 0u}, t1 = {0u, 0u, 0u, 0u};
          if (!first) { t2 = *(const v4u*)(AG + (size_t)(r0 - 2) * FF2 + c0); t1 = *(const v4u*)(AG + (size_t)(r0 - 1) * FF2 + c0); }
#pragma unroll
          for (int e = 0; e < 4; ++e) { p2[2 * e] = bf_lo(t2[e]); p2[2 * e + 1] = bf_hi(t2[e]); p1[2 * e] = bf_lo(t1[e]); p1[2 * e + 1] = bf_hi(t1[e]); } }
#pragma unroll 4
        for (int rr = 0; rr < RB; ++rr) { const int r = r0 + rr;
            const v4u ta = *(const v4u*)(AG + (size_t)r * FF2 + c0), tg = *(const v4u*)(AG + (size_t)r * FF2 + FF + c0);
            float a[8], o[8];
#pragma unroll
            for (int e = 0; e < 4; ++e) { a[2 * e] = bf_lo(ta[e]); a[2 * e + 1] = bf_hi(ta[e]); }
#pragma unroll
            for (int e = 0; e < 8; ++e) { const float cv = bb[e] + w0[e] * p2[e] + w1[e] * p1[e] + w2[e] * a[e]; const float gv = (e & 1) ? bf_hi(tg[e >> 1]) : bf_lo(tg[e >> 1]); o[e] = siluf_(cv) * gv; p2[e] = p1[e]; p1[e] = a[e]; }
            v4u w; w.x = cvtpk(o[0], o[1]); w.y = cvtpk(o[2], o[3]); w.z = cvtpk(o[4], o[5]); w.w = cvtpk(o[6], o[7]);
            *(v4u*)(U + (size_t)r * FF + c0) = w;
            if ((r & (SEQ - 1)) >= SEQ - 2) { float* oc = P.out + O_CONVP + ((size_t)(layer * 2 + (r >> 13)) * 2 + ((r & (SEQ - 1)) - (SEQ - 2))) * FF + c0;
                *(f32x4*)oc = (f32x4){a[0], a[1], a[2], a[3]}; *(f32x4*)(oc + 4) = (f32x4){a[4], a[5], a[6], a[7]}; }
        }
    }
    for (int it = gt; it < 256 * NCH; it += NGT) {
        const int s = it / NCH, ch = it % NCH, c0 = ch * 8, r = MP + s;
        v4u w = {0u, 0u, 0u, 0u};
        if (s < NS) {
            const float* sc = P.st_conv + ((size_t)(layer * NS + s) * 2) * FF + c0;
            const v4u ta = *(const v4u*)(AG + (size_t)r * FF2 + c0), tg = *(const v4u*)(AG + (size_t)r * FF2 + FF + c0);
            float o[8], a[8];
#pragma unroll
            for (int e = 0; e < 4; ++e) { a[2 * e] = bf_lo(ta[e]); a[2 * e + 1] = bf_hi(ta[e]); }
#pragma unroll
            for (int e = 0; e < 8; ++e) { const float cv = bc[c0 + e] + wc[c0 + e] * sc[e] + wc[FF + c0 + e] * sc[FF + e] + wc[2 * FF + c0 + e] * a[e];
                const float gv = (e & 1) ? bf_hi(tg[e >> 1]) : bf_lo(tg[e >> 1]); o[e] = siluf_(cv) * gv; }
            w.x = cvtpk(o[0], o[1]); w.y = cvtpk(o[2], o[3]); w.z = cvtpk(o[4], o[5]); w.w = cvtpk(o[6], o[7]);
            float* oc = P.out + O_CONVS + ((size_t)(layer * NS + s) * 2) * FF + c0;
#pragma unroll
            for (int e = 0; e < 8; ++e) { oc[e] = sc[FF + e]; oc[FF + e] = a[e]; }
        }
        *(v4u*)(U + (size_t)r * FF + c0) = w;
    }
}
typedef short v4i16_t __attribute__((ext_vector_type(4)));
#define MFMA16(a, b, c) __builtin_amdgcn_mfma_f32_16x16x32_bf16((a), (b), (c), 0, 0, 0)
__device__ __forceinline__ s16x4 vtr(LAS const unsigned char* p) { return __builtin_bit_cast(s16x4, __builtin_amdgcn_ds_read_tr16_b64_v4i16((LAS v4i16_t*)p)); }
__device__ __forceinline__ bf16x8 tr_frag(LAS const unsigned char* tile, int stride, int krow0, int c0, int lane) {
    const int g = lane >> 4, q = (lane >> 2) & 3, p = lane & 3;
    LAS const unsigned char* a = tile + (krow0 + 8 * g + q) * stride + (c0 + 4 * p) * 2;
    const s16x4 lo = vtr(a), hi = vtr(a + 4 * stride);
    return (bf16x8){lo[0], lo[1], lo[2], lo[3], hi[0], hi[1], hi[2], hi[3]};
}
constexpr int KS_STRIDE = 272, VS_STRIDE = 528, PS_STRIDE = 144;

__device__ __forceinline__ void m1_unit(const Params& P, const Ctx& C, int bh, int c) {
    unsigned char* ws = P.ws; const bf16* QKVO = (const bf16*)(ws + WS_QKVO); const float* GT = (const float*)(ws + WS_GATES);
    bf16* CT = (bf16*)(ws + WS_CT); float* NL = (float*)(ws + WS_NL); float* CHK = (float*)(ws + WS_CHK);
    const int b = bh >> 2, h = bh & 3, r0 = b * SEQ + c * 64, lane = C.lane, tid = C.tid, wave = C.wave;
    LAS unsigned char* Ks = C.lds; LAS unsigned char* Vs = C.lds + 64 * KS_STRIDE;
    const float lf = GT[(size_t)(r0 + lane) * 8 + 4 + h], li = GT[(size_t)(r0 + lane) * 8 + h];
    const float bcum = wave_scan_add(lf, lane); const float g = __shfl(bcum, 63);
    const float a = g - bcum + li; const float mloc = wave_max(a); const float wa = __expf(a - mloc);
    if (tid == 0) { CHK[bh * 128 + c] = g; CHK[1024 + bh * 128 + c] = mloc; }
#pragma unroll
    for (int i = 0; i < 2; ++i) { const int j = (tid >> 4) + 32 * i, ch = tid & 15;
        const v4u kv = *(const v4u*)(QKVO + (size_t)(r0 + j) * NIN + 512 + h * 128 + ch * 8); const float w = __shfl(wa, j);
        v4u o;
#pragma unroll
        for (int e = 0; e < 4; ++e) o[e] = cvtpk(bf_lo(kv[e]) * w, bf_hi(kv[e]) * w);
        *(LAS v4u*)(Ks + j * KS_STRIDE + ch * 16) = o; }
#pragma unroll
    for (int i = 0; i < 4; ++i) { const int j = (tid >> 5) + 16 * i, ch = tid & 31;
        *(LAS v4u*)(Vs + j * VS_STRIDE + ch * 16) = *(const v4u*)(QKVO + (size_t)(r0 + j) * NIN + 1024 + h * 256 + ch * 8); }
    __syncthreads();
    if (tid < 128) { float s = 0.f;
#pragma unroll 8
        for (int j = 0; j < 64; ++j) s += bf2f(*(LAS const bf16*)(Ks + j * KS_STRIDE + tid * 2));
        NL[(size_t)(bh * 128 + c) * 128 + tid] = s; }
    f32x4 acc[8][2];
#pragma unroll
    for (int dt = 0; dt < 8; ++dt) { acc[dt][0] = (f32x4){0.f, 0.f, 0.f, 0.f}; acc[dt][1] = (f32x4){0.f, 0.f, 0.f, 0.f}; }
#pragma unroll
    for (int ks = 0; ks < 2; ++ks) {
        const bf16x8 bv0 = tr_frag(Vs, VS_STRIDE, 32 * ks, 32 * wave, lane), bv1 = tr_frag(Vs, VS_STRIDE, 32 * ks, 32 * wave + 16, lane);
#pragma unroll
        for (int dt = 0; dt < 8; ++dt) { const bf16x8 ak = tr_frag(Ks, KS_STRIDE, 32 * ks, 16 * dt, lane);
            acc[dt][0] = MFMA16(ak, bv0, acc[dt][0]); acc[dt][1] = MFMA16(ak, bv1, acc[dt][1]); }
    }
#pragma unroll
    for (int dt = 0; dt < 8; ++dt)
#pragma unroll
        for (int et = 0; et < 2; ++et) { const int e = 32 * wave + 16 * et + (lane & 15), d0 = 16 * dt + 4 * (lane >> 4);
            u32x2 w; w.x = cvtpk(acc[dt][et][0], acc[dt][et][1]); w.y = cvtpk(acc[dt][et][2], acc[dt][et][3]);
            *(u32x2*)(CT + ((size_t)(bh * 128 + c) * 256 + e) * 128 + d0) = w; }
    __syncthreads();
}

__device__ __forceinline__ void mstep_unit(const Params& P, const Ctx& C, int s, int h) {
    unsigned char* ws = P.ws; const bf16* QKVO = (const bf16*)(ws + WS_QKVO); const float* GT = (const float*)(ws + WS_GATES); bf16* HH = (bf16*)(ws + WS_XN);
    const int r = MP + s, tid = C.tid, lane = C.lane, wave = C.wave;
    LAS float* qs = (LAS float*)C.lds; LAS float* red = qs + 512; LAS float* misc = qs + 512 + 2048;
    { const bf16* src = QKVO + (size_t)r * NIN; float val;
      if (tid < 128) val = bf2f(src[h * 128 + tid]); else if (tid < 256) val = bf2f(src[512 + h * 128 + (tid - 128)]); else val = bf2f(src[1024 + h * 256 + (tid - 256)]);
      qs[tid] = val; }
    const float li = GT[(size_t)r * 8 + h], lf = GT[(size_t)r * 8 + 4 + h], m_st = P.st_m[s * 4 + h];
    const float m_new = fmaxf(lf + m_st, li), fw = __expf(lf + m_st - m_new), iw = __expf(li - m_new);
    __syncthreads();
    const int e4 = (tid & 63) * 4;
    f32x4 num = {0.f, 0.f, 0.f, 0.f}; const f32x4 vv = *(LAS const f32x4*)(qs + 256 + e4);
    const size_t cbase = (size_t)(s * 4 + h) * 128 * 256;
#pragma unroll
    for (int dd = 0; dd < 16; ++dd) { const int d = 16 * wave + dd; const f32x4 c4 = *(const f32x4*)(P.st_C + cbase + (size_t)d * 256 + e4); const float kd = qs[128 + d], qd = qs[d];
        const f32x4 cn = c4 * fw + vv * (iw * kd); *(f32x4*)(P.out + O_CS + cbase + (size_t)d * 256 + e4) = cn; num += cn * qd; }
    *(LAS f32x4*)(red + wave * 256 + e4) = num;
    float dpart = 0.f;
    if (tid < 128) { const float nn = fw * P.st_n[(size_t)(s * 4 + h) * 128 + tid] + iw * qs[128 + tid]; P.out[O_NS + (size_t)(s * 4 + h) * 128 + tid] = nn; dpart = qs[tid] * nn; }
    dpart = wave_sum(dpart); if (lane == 0) misc[wave] = dpart;
    __syncthreads();
    const float den = misc[0] + misc[1]; const float inv = 1.0f / fmaxf(fabsf(den), __expf(-m_new));
    float hv = 0.f;
    if (tid < 256) { float sum = 0.f;
#pragma unroll
        for (int w = 0; w < 8; ++w) sum += red[w * 256 + tid];
        hv = sum * inv; }
    const float ss = wave_sum(hv * hv); if (lane == 0) misc[8 + wave] = ss;
    __syncthreads();
    float tot = 0.f;
#pragma unroll
    for (int w = 0; w < 8; ++w) tot += misc[8 + w];
    const float rstd = rsqrtf(tot * (1.f / 256.f) + EPSN);
    if (tid < 256) { const float og = bf2f(QKVO[(size_t)r * NIN + 2048 + h * 256 + tid]); const float o = hv * rstd * P.g_m_head[h * 256 + tid] * sigmoidf_(og);
        HH[(size_t)r * DM + h * 256 + tid] = (bf16)(cvtpk(o, 0.f) & 0xffffu); }
    if (tid == 0) P.out[O_MS + s * 4 + h] = m_new;
    __syncthreads();
}

__device__ __forceinline__ void m2_scan(const Params& P, const Ctx& C) {
    unsigned char* ws = P.ws; unsigned* CT32 = (unsigned*)(ws + WS_CT); float* NL = (float*)(ws + WS_NL); float* CHK = (float*)(ws + WS_CHK);
    const int gt = C.vcu * NTHREADS + C.tid, NGT = C.G * NTHREADS;
    for (int idx = gt; idx < 8 * 16384; idx += NGT) {
        const int bh = idx >> 14, p = idx & 16383, e = p >> 6, d = (p & 63) * 2;
        unsigned* ct = CT32 + (((size_t)bh * 128 * 256 + e) * 128 + d) / 2;
        const bool do_n = p < 128; float* nl = NL + (size_t)bh * 128 * 128 + (do_n ? p : 0);
        float c0 = 0.f, c1 = 0.f, m = 0.f, nst = 0.f;
        for (int cb = 0; cb < 128; cb += 8) {
            unsigned cur[8]; float nv[8];
#pragma unroll
            for (int k = 0; k < 8; ++k) { cur[k] = ct[(size_t)(cb + k) * 16384]; nv[k] = do_n ? nl[(cb + k) * 128] : 0.f; }
#pragma unroll
            for (int k = 0; k < 8; ++k) { const int c = cb + k; const float g = CHK[bh * 128 + c], ml = CHK[1024 + bh * 128 + c];
                const float m_new = fmaxf(g + m, ml), fw = __expf(g + m - m_new), lw = __expf(ml - m_new);
                ct[(size_t)c * 16384] = cvtpk(c0, c1); c0 = fw * c0 + lw * bf_lo(cur[k]); c1 = fw * c1 + lw * bf_hi(cur[k]);
                if (do_n) { nl[c * 128] = nst; nst = fw * nst + lw * nv[k]; }
                if (p == 0) CHK[2048 + bh * 128 + c] = m;
                m = m_new; }
        }
        P.out[O_CP + ((size_t)bh * 128 + d) * 256 + e] = c0; P.out[O_CP + ((size_t)bh * 128 + d + 1) * 256 + e] = c1;
        if (do_n) P.out[O_NP + bh * 128 + p] = nst;
        if (p == 0) P.out[O_MP + bh] = m;
    }
}

__device__ __forceinline__ void m3_unit(const Params& P, const Ctx& C, int bh, int c) {
    unsigned char* ws = P.ws; const bf16* QKVO = (const bf16*)(ws + WS_QKVO); const float* GT = (const float*)(ws + WS_GATES);
    const bf16* CT = (const bf16*)(ws + WS_CT); const float* NL = (const float*)(ws + WS_NL); const float* CHK = (const float*)(ws + WS_CHK); bf16* HH = (bf16*)(ws + WS_XN);
    const int b = bh >> 2, h = bh & 3, r0 = b * SEQ + c * 64, lane = C.lane, tid = C.tid, wave = C.wave, g = lane >> 4, l15 = lane & 15;
    LAS unsigned char* Qs = C.lds; LAS unsigned char* Ks = C.lds + 17408; LAS unsigned char* Vs = C.lds + 34816; LAS unsigned char* Ps = C.lds + 68608;
    LAS float* sb = (LAS float*)(C.lds + 77824); LAS float* su = sb + 64; LAS float* sms = sb + 128; LAS float* swi = sb + 192; LAS float* sqn = sb + 256; LAS float* dsum = sb + 320; LAS float* ssq = sb + 576;
    { const float lf = GT[(size_t)(r0 + lane) * 8 + 4 + h], li = GT[(size_t)(r0 + lane) * 8 + h];
      const float bcum = wave_scan_add(lf, lane); const float u = li - bcum; const float pm = wave_scan_max(u, lane); const float mprev = CHK[2048 + bh * 128 + c];
      const float w0 = bcum + mprev, ms = fmaxf(w0, bcum + pm), wi = __expf(w0 - ms);
      if (wave == 0) { sb[lane] = bcum - ms; su[lane] = u; sms[lane] = ms; swi[lane] = wi; } }
    bf16x8 bC[2][4];
#pragma unroll
    for (int et = 0; et < 2; ++et)
#pragma unroll
        for (int ks = 0; ks < 4; ++ks) bC[et][ks] = *(const bf16x8*)(CT + ((size_t)(bh * 128 + c) * 256 + 32 * wave + 16 * et + l15) * 128 + 32 * ks + 8 * g);
#pragma unroll
    for (int i = 0; i < 2; ++i) { const int j = (tid >> 4) + 32 * i, ch = tid & 15; const bf16* src = QKVO + (size_t)(r0 + j) * NIN + h * 128 + ch * 8;
        *(LAS v4u*)(Qs + j * KS_STRIDE + ch * 16) = *(const v4u*)src; *(LAS v4u*)(Ks + j * KS_STRIDE + ch * 16) = *(const v4u*)(src + 512); }
#pragma unroll
    for (int i = 0; i < 4; ++i) { const int j = (tid >> 5) + 16 * i, ch = tid & 31;
        *(LAS v4u*)(Vs + j * VS_STRIDE + ch * 16) = *(const v4u*)(QKVO + (size_t)(r0 + j) * NIN + 1024 + h * 256 + ch * 8); }
    __syncthreads();
    { const int i = 8 * wave + (lane >> 3), d0 = (lane & 7) * 16; float s = 0.f; const float* np = NL + (size_t)(bh * 128 + c) * 128 + d0;
#pragma unroll
      for (int dd = 0; dd < 16; ++dd) s += bf2f(*(LAS const bf16*)(Qs + i * KS_STRIDE + (d0 + dd) * 2)) * np[dd];
      s += __shfl_xor(s, 1); s += __shfl_xor(s, 2); s += __shfl_xor(s, 4); if ((lane & 7) == 0) sqn[i] = s; }
    { const int jt = wave >> 1;
#pragma unroll
      for (int tt = 0; tt < 2; ++tt) { const int it = 2 * (wave & 1) + tt, i = 16 * it + l15;
          u32x2 pw = {0u, 0u}; float psum = 0.f;
          if (jt <= it) { f32x4 sacc = {0.f, 0.f, 0.f, 0.f};
#pragma unroll
              for (int ks = 0; ks < 4; ++ks) { const bf16x8 a = *(LAS const bf16x8*)(Ks + (16 * jt + l15) * KS_STRIDE + (32 * ks + 8 * g) * 2), bq = *(LAS const bf16x8*)(Qs + (16 * it + l15) * KS_STRIDE + (32 * ks + 8 * g) * 2);
                  sacc = MFMA16(a, bq, sacc); }
              const float bim = sb[i]; float pv[4];
#pragma unroll
              for (int ii = 0; ii < 4; ++ii) { const int j = 16 * jt + 4 * g + ii; pv[ii] = (j <= i) ? sacc[ii] * __expf(bim + su[j]) : 0.f; psum += pv[ii]; }
              pw.x = cvtpk(pv[0], pv[1]); pw.y = cvtpk(pv[2], pv[3]); }
          *(LAS u32x2*)(Ps + i * PS_STRIDE + (16 * jt + 4 * g) * 2) = pw;
          psum += __shfl_xor(psum, 16); psum += __shfl_xor(psum, 32); if (g == 0) dsum[jt * 64 + i] = psum; } }
    __syncthreads();
    f32x4 ai[4][2], ax[4][2];
#pragma unroll
    for (int it = 0; it < 4; ++it)
#pragma unroll
        for (int et = 0; et < 2; ++et) { ai[it][et] = (f32x4){0.f, 0.f, 0.f, 0.f}; ax[it][et] = (f32x4){0.f, 0.f, 0.f, 0.f}; }
#pragma unroll
    for (int ks = 0; ks < 4; ++ks)
#pragma unroll
        for (int it = 0; it < 4; ++it) { const bf16x8 aq = *(LAS const bf16x8*)(Qs + (16 * it + l15) * KS_STRIDE + (32 * ks + 8 * g) * 2);
            ai[it][0] = MFMA16(aq, bC[0][ks], ai[it][0]); ai[it][1] = MFMA16(aq, bC[1][ks], ai[it][1]); }
#pragma unroll
    for (int ks = 0; ks < 2; ++ks) { const bf16x8 bv0 = tr_frag(Vs, VS_STRIDE, 32 * ks, 32 * wave, lane), bv1 = tr_frag(Vs, VS_STRIDE, 32 * ks, 32 * wave + 16, lane);
#pragma unroll
        for (int it = 0; it < 4; ++it) { const bf16x8 ap = *(LAS const bf16x8*)(Ps + (16 * it + l15) * PS_STRIDE + (32 * ks + 8 * g) * 2);
            ax[it][0] = MFMA16(ap, bv0, ax[it][0]); ax[it][1] = MFMA16(ap, bv1, ax[it][1]); } }
#pragma unroll
    for (int it = 0; it < 4; ++it)
#pragma unroll
        for (int ii = 0; ii < 4; ++ii) { const int i = 16 * it + 4 * g + ii; const float wi = swi[i];
            const float den = wi * sqn[i] + (dsum[i] + dsum[64 + i]) + (dsum[128 + i] + dsum[192 + i]); const float inv = 1.0f / fmaxf(fabsf(den), __expf(-sms[i]));
            const float h0 = (wi * ai[it][0][ii] + ax[it][0][ii]) * inv, h1 = (wi * ai[it][1][ii] + ax[it][1][ii]) * inv; ai[it][0][ii] = h0; ai[it][1][ii] = h1;
            float ss = h0 * h0 + h1 * h1; ss += __shfl_xor(ss, 1); ss += __shfl_xor(ss, 2); ss += __shfl_xor(ss, 4); ss += __shfl_xor(ss, 8);
            if (l15 == 0) ssq[wave * 64 + i] = ss; }
    __syncthreads();
#pragma unroll
    for (int it = 0; it < 4; ++it)
#pragma unroll
        for (int ii = 0; ii < 4; ++ii) { const int i = 16 * it + 4 * g + ii; float tot = 0.f;
#pragma unroll
            for (int w = 0; w < 8; ++w) tot += ssq[w * 64 + i];
            const float rstd = rsqrtf(tot * (1.f / 256.f) + EPSN);
#pragma unroll
            for (int et = 0; et < 2; ++et) { const int e = 32 * wave + 16 * et + l15; const float og = bf2f(QKVO[(size_t)(r0 + i) * NIN + 2048 + h * 256 + e]);
                const float o = ai[it][et][ii] * rstd * P.g_m_head[h * 256 + e] * sigmoidf_(og); HH[(size_t)(r0 + i) * DM + h * 256 + e] = (bf16)(cvtpk(o, 0.f) & 0xffffu); } }
    __syncthreads();
}
namespace att {
constexpr int QB = 256, KVBLK = 64, NSLOT = 3, KSLOT = 12288, VSLOT = 8192;
constexpr int LDS_K = 0, LDS_V = NSLOT * KSLOT, LDS_WS = LDS_V + NSLOT * VSLOT, LDS_OST = LDS_WS + 8 * 256, LDS_BYTES = LDS_OST + 8 * 4096;
#define MFMA32(a, b, c) __builtin_amdgcn_mfma_f32_32x32x16_bf16((a), (b), (c), 0, 0, 0)
__device__ __forceinline__ int crow(int r, int hi) { return (r & 3) + 8 * (r >> 2) + 4 * hi; }
__device__ __forceinline__ void glds16(const void* gsrc, unsigned lds_dst) { unsigned keep;
    asm volatile("s_mov_b32 %0, m0\n\ts_mov_b32 m0, %2\n\ts_nop 0\n\tglobal_load_lds_dwordx4 %1, off\n\ts_mov_b32 m0, %0" : "=&s"(keep) : "v"(gsrc), "s"(lds_dst) : "memory"); }
#define MX3(a, b, c) __builtin_fmaxf(__builtin_fmaxf((a), (b)), (c))
__device__ __forceinline__ float rowmax(const f32x16& p0, const f32x16& p1) {
    float a = MX3(p0[0], p0[1], p1[0]), b = MX3(p0[2], p0[3], p1[1]); a = MX3(a, p1[2], p1[3]);
#pragma unroll
    for (int r = 4; r < 16; r += 4) { a = MX3(a, p0[r], p0[r + 1]); b = MX3(b, p0[r + 2], p0[r + 3]); a = MX3(a, p1[r], p1[r + 1]); b = MX3(b, p1[r + 2], p1[r + 3]); }
    float m = __builtin_fmaxf(a, b); auto rr = __builtin_amdgcn_permlane32_swap(__float_as_uint(m), __float_as_uint(m), false, false);
    return __builtin_fmaxf(__uint_as_float(rr[0]), __uint_as_float(rr[1])); }
__device__ __forceinline__ void cmask(f32x16& p0, f32x16& p1, int jb, int qrel, int hi) {
    const int kb = 64 * jb + 4 * hi;
#pragma unroll
    for (int r = 0; r < 16; ++r) { const int kv = kb + (r & 3) + 8 * (r >> 2); if (kv > qrel) p0[r] = -INFINITY; if (kv + 32 > qrel) p1[r] = -INFINITY; } }

__device__ __forceinline__ void attn_unit(int b, int h, int qb, const bf16* Q, const bf16* __restrict__ KN, const bf16* __restrict__ KPE, const bf16* __restrict__ V, bf16* O, const float* __restrict__ tab, LAS unsigned char* shm) {
    const int tid = threadIdx.x, lane = tid & 63, r32 = lane & 31, hi = lane >> 5; const int wid = __builtin_amdgcn_readfirstlane(tid >> 6);
    const long rowbase = (long)b * SEQ; const int q0 = qb * QB, NT = (q0 + QB) / KVBLK;
    const bf16* Qw = Q + (rowbase + q0 + wid * 32) * QW + h * 96;
    const unsigned lds0 = (unsigned)(uintptr_t)shm; LAS float* wsf = (LAS float*)(shm + LDS_WS) + wid * 64;
    const bf16* ksrc = KN + (rowbase + lane) * DM + h * 64 + wid * 8;
    const bf16* psrc = KPE + (rowbase + lane) * 32 + (wid & 3) * 8;
    const bf16* vsrc = V + (rowbase + 16 * (wid & 3) + (lane >> 2)) * DM + h * 64 + (wid >> 2) * 32 + (lane & 3) * 8;
    const unsigned kdst = lds0 + LDS_K + wid * 1024, pdst = lds0 + LDS_K + (8 + (wid & 3)) * 1024, vdst = lds0 + LDS_V + wid * 1024;
#define DMA_T(t, sl) do { glds16(ksrc + (long)(t) * KVBLK * DM, (unsigned)__builtin_amdgcn_readfirstlane(kdst + (sl) * KSLOT)); \
                          glds16(psrc + (long)(t) * KVBLK * 32, (unsigned)__builtin_amdgcn_readfirstlane(pdst + (sl) * KSLOT)); \
                          glds16(vsrc + (long)(t) * KVBLK * DM, (unsigned)__builtin_amdgcn_readfirstlane(vdst + (sl) * VSLOT)); } while (0)
    bf16x8 qr[6];
#pragma unroll
    for (int d0 = 0; d0 < 6; ++d0) qr[d0] = *reinterpret_cast<const bf16x8*>(&Qw[(long)r32 * QW + d0 * 16 + hi * 8]);
    {
      const int pos = q0 + wid * 32 + r32; const float* cp = tab + pos * 16 + 8 * hi; const float* sp = cp + 8193 * 16;
      const f32x4 c0 = *(const f32x4*)cp, c1 = *(const f32x4*)(cp + 4), s0 = *(const f32x4*)sp, s1 = *(const f32x4*)(sp + 4);
      const v4u a = __builtin_bit_cast(v4u, qr[4]), bq = __builtin_bit_cast(v4u, qr[5]); v4u oa, ob;
#pragma unroll
      for (int e = 0; e < 4; ++e) { const float cl = e < 2 ? c0[2 * e] : c1[2 * e - 4], ch = e < 2 ? c0[2 * e + 1] : c1[2 * e - 3], sl_ = e < 2 ? s0[2 * e] : s1[2 * e - 4], sh = e < 2 ? s0[2 * e + 1] : s1[2 * e - 3];
          const float x1l = bf_lo(a[e]), x1h = bf_hi(a[e]), x2l = bf_lo(bq[e]), x2h = bf_hi(bq[e]);
          oa[e] = cvtpk(x1l * cl - x2l * sl_, x1h * ch - x2h * sh); ob[e] = cvtpk(x1l * sl_ + x2l * cl, x1h * sh + x2h * ch); }
      qr[4] = __builtin_bit_cast(bf16x8, oa); qr[5] = __builtin_bit_cast(bf16x8, ob); }
    DMA_T(0, 0); DMA_T(1, 1);
    float m_run = -1e30f, l_reg = 0.f; f32x16 o[2]; o[0] = f32x16{}; o[1] = f32x16{};
    const int qrel = wid * 32 + r32;
    const LAS unsigned char* shm3 = shm;
    int sl = 0;
    for (int t = 0; t < NT; ++t) {
        if (t + 1 < NT) asm volatile("s_waitcnt vmcnt(3) lgkmcnt(0)\n\ts_barrier" ::: "memory"); else asm volatile("s_waitcnt vmcnt(0) lgkmcnt(0)\n\ts_barrier" ::: "memory");
        if (t + 2 < NT) { const int s2 = (sl == 0) ? 2 : sl - 1; DMA_T(t + 2, s2); }
        f32x16 p0 = f32x16{}, p1 = f32x16{};
        { const LAS unsigned char* kb = shm3 + LDS_K + sl * KSLOT + hi * 1024 + r32 * 16;
#pragma unroll
          for (int d0 = 0; d0 < 6; ++d0) { const bf16x8 b0 = *(const LAS bf16x8*)(kb + d0 * 2048), b1 = *(const LAS bf16x8*)(kb + d0 * 2048 + 512);
              p0 = MFMA32(b0, qr[d0], p0); p1 = MFMA32(b1, qr[d0], p1); } }
        if (t >= NT - 4) cmask(p0, p1, t - (NT - 4), qrel, hi);
        const float rm = rowmax(p0, p1); const float m_new = fmaxf(m_run, rm); const float alpha = __builtin_amdgcn_exp2f(m_run - m_new); m_run = m_new;
        float sacc = 0.f;
#pragma unroll
        for (int r = 0; r < 16; ++r) { p0[r] = __builtin_amdgcn_exp2f(p0[r] - m_new); p1[r] = __builtin_amdgcn_exp2f(p1[r] - m_new); sacc += p0[r] + p1[r]; }
        l_reg = l_reg * alpha + sacc;
        if (__any(alpha != 1.0f)) { if (hi == 0) wsf[r32] = alpha; asm volatile("s_waitcnt lgkmcnt(0)" ::: "memory");
#pragma unroll
            for (int d_ = 0; d_ < 2; ++d_)
#pragma unroll
                for (int r = 0; r < 16; ++r) o[d_][r] *= wsf[crow(r, hi)];
            asm volatile("s_waitcnt lgkmcnt(0)" ::: "memory"); }
        bf16x8 pa[4];
#pragma unroll
        for (int k = 0; k < 2; ++k) { v4u w0, w1;
#pragma unroll
            for (int e = 0; e < 4; ++e) { w0[e] = cvtpk(p0[8 * k + 2 * e], p0[8 * k + 2 * e + 1]); w1[e] = cvtpk(p1[8 * k + 2 * e], p1[8 * k + 2 * e + 1]); }
            pa[k] = __builtin_bit_cast(bf16x8, w0); pa[2 + k] = __builtin_bit_cast(bf16x8, w1); }
        { const LAS unsigned char* vb = shm3 + LDS_V + sl * VSLOT + ((lane >> 4) & 1) * 32 + (lane & 3) * 8 + (4 * hi + ((lane & 15) >> 2)) * 64;
#pragma unroll
          for (int d0 = 0; d0 < 2; ++d0)
#pragma unroll
              for (int ks = 0; ks < 4; ++ks) { const s16x4 lo = vtr(vb + d0 * 4096 + ks * 1024), hh = vtr(vb + d0 * 4096 + ks * 1024 + 512);
                  const bf16x8 vf = (bf16x8){lo[0], lo[1], lo[2], lo[3], hh[0], hh[1], hh[2], hh[3]};
                  o[d0] = MFMA32(pa[ks], vf, o[d0]); } }
        sl = (sl == 2) ? 0 : sl + 1;
    }
    { auto rr = __builtin_amdgcn_permlane32_swap(__float_as_uint(l_reg), __float_as_uint(l_reg), false, false); l_reg = __uint_as_float(rr[0]) + __uint_as_float(rr[1]); }
    if (hi == 0) wsf[32 + r32] = l_reg; asm volatile("s_waitcnt lgkmcnt(0)" ::: "memory");
    float rli[16];
#pragma unroll
    for (int r = 0; r < 16; ++r) rli[r] = __builtin_amdgcn_rcpf(wsf[32 + crow(r, hi)]);
    bf16* Ow = O + (rowbase + q0 + wid * 32) * DM + h * 64;
    { LAS bf16* stg = (LAS bf16*)(shm + LDS_OST) + wid * 2048;
#pragma unroll
      for (int r = 0; r < 16; ++r) { const int orow = crow(r, hi);
#pragma unroll
          for (int d0 = 0; d0 < 2; ++d0) stg[orow * 64 + d0 * 32 + r32] = (bf16)(cvtpk(o[d0][r] * rli[r], 0.f) & 0xffffu); }
      asm volatile("s_waitcnt lgkmcnt(0)" ::: "memory");
#pragma unroll
      for (int i = 0; i < 4; ++i) { const int row = i * 8 + (lane >> 3), ch = lane & 7; const v4u v = *(const LAS v4u*)(stg + row * 64 + ch * 8); *(v4u*)(Ow + (long)row * DM + ch * 8) = v; } }
    asm volatile("s_waitcnt vmcnt(0) lgkmcnt(0)\n\ts_barrier" ::: "memory");
#undef DMA_T
}
}
namespace dec {
constexpr int TS = 592, TILE_BYTES = 64 * TS;
constexpr int L_T0 = 0, L_QS = 2 * TILE_BYTES, L_QF = L_QS + 16 * TS, L_END = L_QF + QW * 4;
constexpr int PART_STRIDE = 4096 + 32;

__device__ __forceinline__ void decode_unit(const Params& P, const Ctx& C, int s, int half) {
    unsigned char* ws = P.ws; const bf16* Q = (const bf16*)(ws + WS_Q); const bf16* WKV = (const bf16*)(ws + WS_WKV); float* PART = (float*)(ws + WS_PART); bf16* QLS = (bf16*)(ws + WS_QLS);
    const int r = MP + s, tid = C.tid, lane = C.lane, wave = C.wave, g = lane >> 4, l15 = lane & 15;
    LAS unsigned char* Qs = C.lds + L_QS; LAS float* qf = (LAS float*)(C.lds + L_QF);
    for (int i = tid; i < QW; i += NTHREADS) qf[i] = bf2f(Q[(size_t)r * QW + i]);
    __syncthreads();
    { const int c = tid & 255, hh = tid >> 8;
#pragma unroll 1
      for (int h8 = 0; h8 < 8; ++h8) { const int h = 8 * hh + h8; float acc = 0.f; const bf16* wp = WKV + (size_t)(h * 64) * 256 + c;
#pragma unroll 16
          for (int d = 0; d < 64; ++d) acc += qf[h * 96 + d] * bf2f(wp[(size_t)d * 256]);
          *(LAS bf16*)(Qs + h * TS + c * 2) = (bf16)(cvtpk(acc, 0.f) & 0xffffu); }
      { const int h = tid >> 5, rr = tid & 31, i = rr & 15; const float* tab = (const float*)(ws + WS_ROPE) + SEQ * 16;
        const float x1 = qf[h * 96 + 64 + i], x2 = qf[h * 96 + 80 + i], cc = tab[i], sn = tab[8193 * 16 + i];
        const float o = rr < 16 ? x1 * cc - x2 * sn : x1 * sn + x2 * cc;
        *(LAS bf16*)(Qs + h * TS + (256 + rr) * 2) = (bf16)(cvtpk(o, 0.f) & 0xffffu); } }
    __syncthreads();
    bf16x8 qfr[9];
#pragma unroll
    for (int ks = 0; ks < 9; ++ks) qfr[ks] = *(LAS const bf16x8*)(Qs + l15 * TS + (32 * ks + 8 * g) * 2);
    if (half == 0) { for (int i = tid; i < 16 * 288; i += NTHREADS) { const int h = i / 288, c = i % 288; QLS[(size_t)s * 16 * 288 + i] = *(LAS const bf16*)(Qs + h * TS + c * 2); } }
    const int* pt = P.page_table + s * 64 + 32 * half;
    f32x4 ld[8], ldp;
#define DEC_LOAD(tt) do { const int phys_ = pt[(tt) >> 1]; const size_t krow_ = (size_t)phys_ * 128 + ((tt) & 1) * 64; \
        _Pragma("unroll") for (int i_ = 0; i_ < 8; ++i_) { const int e_ = tid + 512 * i_; ld[i_] = *(const f32x4*)(P.cache_ckv + (krow_ + (e_ >> 6)) * 256 + (e_ & 63) * 4); } \
        ldp = *(const f32x4*)(P.cache_kpe + (krow_ + (tid >> 3)) * 32 + (tid & 7) * 4); } while (0)
#define DEC_STORE(buf) do { LAS unsigned char* b_ = C.lds + (buf) * TILE_BYTES; \
        _Pragma("unroll") for (int i_ = 0; i_ < 8; ++i_) { const int e_ = tid + 512 * i_; u32x2 w_; w_.x = cvtpk(ld[i_][0], ld[i_][1]); w_.y = cvtpk(ld[i_][2], ld[i_][3]); *(LAS u32x2*)(b_ + (e_ >> 6) * TS + (e_ & 63) * 8) = w_; } \
        { u32x2 w_; w_.x = cvtpk(ldp[0], ldp[1]); w_.y = cvtpk(ldp[2], ldp[3]); *(LAS u32x2*)(b_ + (tid >> 3) * TS + 512 + (tid & 7) * 8) = w_; } } while (0)
    float m_run = -1e30f, l_run = 0.f; f32x4 oacc[2]; oacc[0] = (f32x4){0.f, 0.f, 0.f, 0.f}; oacc[1] = (f32x4){0.f, 0.f, 0.f, 0.f};
    DEC_LOAD(0); DEC_STORE(0);
    __syncthreads();
    for (int tt = 0; tt < 64; ++tt) {
        if (tt + 1 < 64) DEC_LOAD(tt + 1);
        const LAS unsigned char* buf = C.lds + (tt & 1) * TILE_BYTES;
        f32x4 sT[4];
#pragma unroll
        for (int kt = 0; kt < 4; ++kt) { sT[kt] = (f32x4){0.f, 0.f, 0.f, 0.f};
#pragma unroll
            for (int ks = 0; ks < 9; ++ks) { const bf16x8 a = *(const LAS bf16x8*)(buf + (16 * kt + l15) * TS + (32 * ks + 8 * g) * 2); sT[kt] = MFMA16(a, qfr[ks], sT[kt]); } }
        float mx = fmaxf(fmaxf(sT[0][0], sT[0][1]), fmaxf(sT[0][2], sT[0][3]));
#pragma unroll
        for (int kt = 1; kt < 4; ++kt) mx = fmaxf(mx, fmaxf(fmaxf(sT[kt][0], sT[kt][1]), fmaxf(sT[kt][2], sT[kt][3])));
        mx = fmaxf(mx, __shfl_xor(mx, 16)); mx = fmaxf(mx, __shfl_xor(mx, 32));
        const float m_new = fmaxf(m_run, mx), alpha = __builtin_amdgcn_exp2f(m_run - m_new); m_run = m_new;
        float sum = 0.f;
#pragma unroll
        for (int kt = 0; kt < 4; ++kt)
#pragma unroll
            for (int i = 0; i < 4; ++i) { const float p = __builtin_amdgcn_exp2f(sT[kt][i] - m_new); sT[kt][i] = p; sum += p; }
        sum += __shfl_xor(sum, 16); sum += __shfl_xor(sum, 32);
        l_run = l_run * alpha + sum;
#pragma unroll
        for (int i = 0; i < 4; ++i) { const float ai = __shfl(alpha, 4 * g + i); oacc[0][i] *= ai; oacc[1][i] *= ai; }
#pragma unroll
        for (int kk = 0; kk < 2; ++kk) { v4u pw; pw.x = cvtpk(sT[2 * kk][0], sT[2 * kk][1]); pw.y = cvtpk(sT[2 * kk][2], sT[2 * kk][3]); pw.z = cvtpk(sT[2 * kk + 1][0], sT[2 * kk + 1][1]); pw.w = cvtpk(sT[2 * kk + 1][2], sT[2 * kk + 1][3]);
            const bf16x8 pa = __builtin_bit_cast(bf16x8, pw);
#pragma unroll
            for (int nt = 0; nt < 2; ++nt) { const int c0 = 32 * wave + 16 * nt; const LAS unsigned char* a0 = buf + (32 * kk + 4 * g + ((lane >> 2) & 3)) * TS + (c0 + 4 * (lane & 3)) * 2;
                const s16x4 lo = vtr(a0), hi = vtr(a0 + 16 * TS);
                const bf16x8 bfr = (bf16x8){lo[0], lo[1], lo[2], lo[3], hi[0], hi[1], hi[2], hi[3]};
                oacc[nt] = MFMA16(pa, bfr, oacc[nt]); } }
        if (tt + 1 < 64) DEC_STORE((tt + 1) & 1);
        __syncthreads();
    }
    float* pp = PART + (size_t)(s * 2 + half) * PART_STRIDE;
#pragma unroll
    for (int nt = 0; nt < 2; ++nt)
#pragma unroll
        for (int i = 0; i < 4; ++i) pp[(4 * g + i) * 256 + 32 * wave + 16 * nt + l15] = oacc[nt][i];
    if (wave == 0 && g == 0) { pp[4096 + l15] = m_run; pp[4112 + l15] = l_run; }
#undef DEC_LOAD
#undef DEC_STORE
}

__device__ __forceinline__ void combine_unit(const Params& P, const Ctx& C, int s) {
    unsigned char* ws = P.ws; const bf16* WKV = (const bf16*)(ws + WS_WKV); const float* PART = (const float*)(ws + WS_PART); const bf16* QLS = (const bf16*)(ws + WS_QLS);
    const bf16* CKV = (const bf16*)(ws + WS_CKV); const bf16* KPE = (const bf16*)(ws + WS_KPE); bf16* ATT = (bf16*)(ws + WS_XN);
    const int r = MP + s, tid = C.tid; LAS float* olat = (LAS float*)C.lds;
    { const int h = tid >> 5, l32 = tid & 31; const bf16* ql = QLS + ((size_t)s * 16 + h) * 288; float sn = 0.f;
#pragma unroll
      for (int k = 0; k < 9; ++k) { const int c = l32 + 32 * k; const float kv = c < 256 ? bf2f(CKV[(size_t)r * 256 + c]) : bf2f(KPE[(size_t)r * 32 + c - 256]); sn += bf2f(ql[c]) * kv; }
      sn += __shfl_xor(sn, 1); sn += __shfl_xor(sn, 2); sn += __shfl_xor(sn, 4); sn += __shfl_xor(sn, 8); sn += __shfl_xor(sn, 16);
      const float* p0 = PART + (size_t)(2 * s) * PART_STRIDE; const float* p1 = p0 + PART_STRIDE;
      const float m0 = p0[4096 + h], l0 = p0[4112 + h], m1 = p1[4096 + h], l1 = p1[4112 + h];
      const float m = fmaxf(fmaxf(m0, m1), sn), w0 = __builtin_amdgcn_exp2f(m0 - m), w1 = __builtin_amdgcn_exp2f(m1 - m), wn = __builtin_amdgcn_exp2f(sn - m);
      const float inv = 1.0f / (w0 * l0 + w1 * l1 + wn);
#pragma unroll
      for (int k = 0; k < 8; ++k) { const int c = l32 + 32 * k; olat[h * 256 + c] = (w0 * p0[h * 256 + c] + w1 * p1[h * 256 + c] + wn * bf2f(CKV[(size_t)r * 256 + c])) * inv; } }
    __syncthreads();
#pragma unroll
    for (int q = 0; q < 2; ++q) { const int n = 2 * tid + q, h = n >> 6; const bf16* wp = WKV + (size_t)(1024 + n) * 256; float acc = 0.f;
#pragma unroll 4
        for (int k = 0; k < 32; ++k) { const v4u w = *(const v4u*)(wp + 8 * k); const f32x4 a = *(LAS const f32x4*)(olat + h * 256 + 8 * k), b = *(LAS const f32x4*)(olat + h * 256 + 8 * k + 4);
            acc += a[0] * bf_lo(w[0]) + a[1] * bf_hi(w[0]) + a[2] * bf_lo(w[1]) + a[3] * bf_hi(w[1]) + b[0] * bf_lo(w[2]) + b[1] * bf_hi(w[2]) + b[2] * bf_lo(w[3]) + b[3] * bf_hi(w[3]); }
        ATT[(size_t)r * DM + n] = (bf16)(cvtpk(acc, 0.f) & 0xffffu); }
    __syncthreads();
}
}
#ifndef MK_ONE_LAUNCH
#define MK_ONE_LAUNCH 1
#endif
constexpr int N_PHASES = 25;
__global__ void __launch_bounds__(NTHREADS, 2) mk_fwd(Params P) {
    extern __shared__ __attribute__((aligned(16))) unsigned char lds_raw[];
    Ctx C;
    C.lds = (LAS unsigned char*)lds_raw;
    C.tid = threadIdx.x; C.lane = C.tid & 63; C.wave = __builtin_amdgcn_readfirstlane(C.tid >> 6);
    C.G = gridDim.x; { const int bx = blockIdx.x; C.vcu = (C.G % 8 == 0) ? (bx % 8) * (C.G / 8) + bx / 8 : bx; }
    C.gw = C.vcu * NWAVES + C.wave; C.NGW = C.G * NWAVES;
    unsigned char* ws = P.ws;
    volatile LAS unsigned* MISC = (volatile LAS unsigned*)(C.lds + MISC_OFF);
    for (int u = C.tid; u < (LDS_BYTES - LDSCTL_OFF) / 4; u += NTHREADS) ((LAS unsigned*)(C.lds + LDSCTL_OFF))[u] = 0u;
    __syncthreads();
    XcdBarrier bar; bar.bar = (unsigned*)(ws + WS_CTL) + CW_BAR; bar.x = 0; bar.st = nullptr;
    if (MK_ONE_LAUNCH) bar = xcd_barrier_post((unsigned*)(ws + WS_CTL) + CW_BAR, MISC + 8);
    const int lo = P.ph_lo, hi = P.ph_hi;
#ifdef ONLY_PHASE
#define IN(k) (((k) == ONLY_PHASE) && lo <= (k) && (k) < hi)
#else
#define IN(k) (lo <= (k) && (k) < hi)
#endif
#define SEAM(k) do { if (MK_ONE_LAUNCH && IN(k) && IN((k) + 1)) xcd_barrier(bar); } while (0)
    LAS unsigned char* ring = C.lds + RING_OFF;
    const float* MOD = (const float*)(ws + WS_MOD); float* X = (float*)(ws + WS_X);
    bf16* XN = (bf16*)(ws + WS_XN); bf16* XN2 = (bf16*)(ws + WS_XN2);

    if (IN(0)) { p0_prologue(P, C); } SEAM(0);
    if (IN(1)) { pg8::Gemm g{(const bf16*)(ws + WS_AMOD), (const bf16*)(ws + WS_WMOD), 256, NMOD, DM}; pg8::StaticOrder S; S.init(256, NMOD, C.G, (int)blockIdx.x);
        EpiMod E{(float*)(ws + WS_MOD), P.b_ada, P.b_ada_kv};
        pg8::gemm_phase<EpiMod, pg8::StaticOrder, false, true>(ring, g, S, E); } SEAM(1);
    if (IN(2)) { p2_norm_in(P, C); } SEAM(2);
    if (IN(3)) { pg8::Gemm g{XN, (const bf16*)(ws + WS_WIN), MT, NIN, DM}; pg8::StaticOrder S; S.init(MT, NIN, C.G, (int)blockIdx.x);
        pg8::EpiBf16<0> E{(bf16*)(ws + WS_QKVO), NIN, nullptr, 0, 0, 1.f};
        pg8::gemm_phase<pg8::EpiBf16<0>, pg8::StaticOrder, true, true>(ring, g, S, E); } SEAM(3);
    if (IN(4)) { for (int u = C.vcu; u < 1024 + 512; u += C.G) { if (u < 1024) m1_unit(P, C, u >> 7, u & 127); else mstep_unit(P, C, (u - 1024) >> 2, (u - 1024) & 3); } } SEAM(4);
    if (IN(5)) { m2_scan(P, C); } SEAM(5);
    if (IN(6)) { for (int u = C.vcu; u < 1024; u += C.G) m3_unit(P, C, u >> 7, u & 127); } SEAM(6);
    if (IN(7)) { pg8::Gemm g{XN, (const bf16*)(ws + WS_WOUT), MT, DM, DM}; pg8::StaticOrder S; S.init(MT, DM, C.G, (int)blockIdx.x);
        EpiRes E{X, MOD + 2048};
        pg8::gemm_phase<EpiRes, pg8::StaticOrder, true, true>(ring, g, S, E); } SEAM(7);
    if (IN(8)) { norm_rows(P, C, P.g_norm2, 4096, 3072, XN, nullptr, 0, 0, nullptr); } SEAM(8);
    if (IN(9)) { pg8::Gemm g{XN, (const bf16*)(ws + WS_WUP), MT, FF2, DM}; pg8::StaticOrder S; S.init(MT, FF2, C.G, (int)blockIdx.x);
        pg8::EpiBf16<0> E{(bf16*)(ws + WS_AG), FF2, nullptr, 0, 0, 1.f};
        pg8::gemm_phase<pg8::EpiBf16<0>, pg8::StaticOrder, true, true>(ring, g, S, E); } SEAM(9);
    if (IN(10)) { conv_phase(P, C, 0); } SEAM(10);
    if (IN(11)) { pg8::Gemm g{(const bf16*)(ws + WS_U), (const bf16*)(ws + WS_WDOWN), MT, DM, FF}; pg8::StaticOrder S; S.init(MT, DM, C.G, (int)blockIdx.x);
        EpiRes E{X, MOD + 5120};
        pg8::gemm_phase<EpiRes, pg8::StaticOrder, true, true>(ring, g, S, E); } SEAM(11);
    if (IN(12)) { norm_rows(P, C, P.g_norm1 + DM, 7168, 6144, XN, P.g_kv_in, 13312, 12288, XN2); } SEAM(12);
    if (IN(13)) {
        { pg8::Gemm g{XN2, (const bf16*)(ws + WS_WDKV), MT, 512, DM}; pg8::StaticOrder S; S.init(MT, 512, C.G, (int)blockIdx.x);
          EpiF32 E{(float*)(ws + WS_LAT), 512}; pg8::gemm_phase<EpiF32, pg8::StaticOrder, true, true>(ring, g, S, E); }
        { pg8::Gemm g{XN, (const bf16*)(ws + WS_WDQ), MT, 512, DM}; pg8::StaticOrder S; S.init(MT, 512, C.G, (int)blockIdx.x);
          EpiF32 E{(float*)(ws + WS_QLAT), 512}; pg8::gemm_phase<EpiF32, pg8::StaticOrder, true, true>(ring, g, S, E); } } SEAM(13);
    if (IN(14)) { latent_rows(P, C); } SEAM(14);
    if (IN(15)) {
        { pg8::Gemm g{(const bf16*)(ws + WS_QN), (const bf16*)(ws + WS_WUQ), MT, QW, 384}; pg8::StaticOrder S; S.init(MT, QW, C.G, (int)blockIdx.x);
          pg8::EpiBf16<0> E{(bf16*)(ws + WS_Q), QW, nullptr, 0, 0, 1.f}; pg8::gemm_phase<pg8::EpiBf16<0>, pg8::StaticOrder, true, true>(ring, g, S, E); }
        { pg8::Gemm g{(const bf16*)(ws + WS_CKV), (const bf16*)(ws + WS_WKV), MT, 2048, 256}; pg8::StaticOrder S; S.init(MT, 2048, C.G, (int)blockIdx.x);
          pg8::EpiBf16<0> E{(bf16*)(ws + WS_KN), DM, nullptr, 1024, (size_t)(WS_V - WS_KN) / 2, 1.f}; pg8::gemm_phase<pg8::EpiBf16<0>, pg8::StaticOrder, true, true>(ring, g, S, E); } } SEAM(15);
    if (IN(16)) {
        const bf16* Qb = (const bf16*)(ws + WS_Q); const bf16* KNb = (const bf16*)(ws + WS_KN); const bf16* KPb = (const bf16*)(ws + WS_KPE); const bf16* Vb = (const bf16*)(ws + WS_V);
        if (C.G == 256) { const int bhh = C.vcu >> 3, s = C.vcu & 7;
            for (int i = 0; i < 4; ++i) { const int qb = (i == 0) ? s : (i == 1) ? 15 - s : (i == 2) ? 16 + s : 31 - s; att::attn_unit(bhh >> 4, bhh & 15, qb, Qb, KNb, KPb, Vb, XN, (const float*)(ws + WS_ROPE), ring); } }
        else { for (int u = C.vcu; u < 1024; u += C.G) att::attn_unit(u >> 9, (u >> 5) & 15, u & 31, Qb, KNb, KPb, Vb, XN, (const float*)(ws + WS_ROPE), ring); } } SEAM(16);
    if (IN(17)) { for (int u = C.vcu; u < 256; u += C.G) dec::decode_unit(P, C, u >> 1, u & 1); } SEAM(17);
    if (IN(18)) { for (int u = C.vcu; u < NS; u += C.G) dec::combine_unit(P, C, u); } SEAM(18);
    if (IN(19)) { pg8::Gemm g{XN, (const bf16*)(ws + WS_WO), MT, DM, DM}; pg8::StaticOrder S; S.init(MT, DM, C.G, (int)blockIdx.x);
        EpiRes E{X, MOD + 8192};
        pg8::gemm_phase<EpiRes, pg8::StaticOrder, true, true>(ring, g, S, E); } SEAM(19);
    if (IN(20)) { norm_rows(P, C, P.g_norm2 + DM, 10240, 9216, XN, nullptr, 0, 0, nullptr); } SEAM(20);
    if (IN(21)) { pg8::Gemm g{XN, (const bf16*)(ws + WS_WUP) + (size_t)FF2 * DM, MT, FF2, DM}; pg8::StaticOrder S; S.init(MT, FF2, C.G, (int)blockIdx.x);
        pg8::EpiBf16<0> E{(bf16*)(ws + WS_AG), FF2, nullptr, 0, 0, 1.f};
        pg8::gemm_phase<pg8::EpiBf16<0>, pg8::StaticOrder, true, true>(ring, g, S, E); } SEAM(21);
    if (IN(22)) { conv_phase(P, C, 1); } SEAM(22);
    if (IN(23)) { pg8::Gemm g{(const bf16*)(ws + WS_U), (const bf16*)(ws + WS_WDOWN) + (size_t)DM * FF, MT, DM, FF}; pg8::StaticOrder S; S.init(MT, DM, C.G, (int)blockIdx.x);
        EpiRes E{X, MOD + 11264};
        pg8::gemm_phase<EpiRes, pg8::StaticOrder, true, true>(ring, g, S, E); } SEAM(23);
    if (IN(24)) { final_norm(P, C); }
#undef IN
#undef SEAM
}

extern "C" void kernel_launch(void* const* d_in, const int* in_sizes, int n_in, void* d_out, int out_size, void* d_ws, size_t ws_size, hipStream_t stream) {
    static int grid = 0;
    if (grid == 0) {
        if (n_in != 35 || out_size != (int)O_END || ws_size < WS_END) { fprintf(stderr, "kernel_launch: unexpected shapes (n_in %d, out %d, ws %zu < %zu); nothing launched\n", n_in, out_size, ws_size, (size_t)WS_END); grid = -1; return; }
        int dev = 0, cus = 0, per_cu = 0;
        if (hipGetDevice(&dev) != hipSuccess || hipDeviceGetAttribute(&cus, hipDeviceAttributeMultiprocessorCount, dev) != hipSuccess) { grid = -1; return; }
        if (hipFuncSetAttribute((const void*)mk_fwd, hipFuncAttributeMaxDynamicSharedMemorySize, LDS_BYTES) != hipSuccess) { fprintf(stderr, "kernel_launch: hipFuncSetAttribute failed\n"); grid = -1; return; }
        if (hipOccupancyMaxActiveBlocksPerMultiprocessor(&per_cu, (const void*)mk_fwd, NTHREADS, LDS_BYTES) != hipSuccess || per_cu < 1)
            fprintf(stderr, "kernel_launch: note: occupancy query reports %d workgroups per CU\n", per_cu);
        (void)hipGetLastError();
        grid = cus;
    }
    if (grid < 0) return;
    if (hipMemsetAsync((char*)d_ws + WS_CTL, 0, CTL_ZERO_BYTES, stream) != hipSuccess) { fprintf(stderr, "kernel_launch: memset failed\n"); return; }
    Params p{};
    p.x_p = (const float*)d_in[0]; p.x_s = (const float*)d_in[1]; p.st_C = (const float*)d_in[2]; p.st_n = (const float*)d_in[3]; p.st_m = (const float*)d_in[4]; p.st_conv = (const float*)d_in[5];
    p.cache_ckv = (const float*)d_in[6]; p.cache_kpe = (const float*)d_in[7]; p.page_table = (const int*)d_in[8]; p.c_p = (const float*)d_in[9]; p.c_s = (const float*)d_in[10];
    p.g_norm1 = (const float*)d_in[11]; p.g_norm2 = (const float*)d_in[12]; p.w_ada = (const float*)d_in[13]; p.b_ada = (const float*)d_in[14]; p.w_up = (const float*)d_in[15];
    p.w_conv = (const float*)d_in[16]; p.b_conv = (const float*)d_in[17]; p.w_down = (const float*)d_in[18]; p.w_m_in = (const float*)d_in[19]; p.b_m_gates = (const float*)d_in[20];
    p.g_m_head = (const float*)d_in[21]; p.w_m_out = (const float*)d_in[22]; p.g_kv_in = (const float*)d_in[23]; p.w_ada_kv = (const float*)d_in[24]; p.b_ada_kv = (const float*)d_in[25];
    p.w_dkv = (const float*)d_in[26]; p.g_kv = (const float*)d_in[27]; p.w_uk = (const float*)d_in[28]; p.w_uv = (const float*)d_in[29]; p.w_dq = (const float*)d_in[30];
    p.g_q = (const float*)d_in[31]; p.w_uq = (const float*)d_in[32]; p.w_o = (const float*)d_in[33]; p.g_final = (const float*)d_in[34];
    p.out = (float*)d_out; p.ws = (unsigned char*)d_ws;
#if MK_ONE_LAUNCH
    p.ph_lo = 0; p.ph_hi = N_PHASES;
    hipLaunchKernelGGL(mk_fwd, dim3(grid), dim3(NTHREADS), LDS_BYTES, stream, p);
#else
    for (int ph = 0; ph < N_PHASES; ++ph) { p.ph_lo = ph; p.ph_hi = ph + 1; hipLaunchKernelGGL(mk_fwd, dim3(grid), dim3(NTHREADS), LDS_BYTES, stream, p); }
#endif
    const hipError_t le = hipPeekAtLastError();
    if (le != hipSuccess) fprintf(stderr, "kernel_launch: launch failed: %s\n", hipGetErrorName(le));
}
```

```cpp
#include <hip/hip_runtime.h>
#include <hip/hip_bf16.h>
#include <cstdio>
#include <cstdint>
#include <cmath>
namespace pg8 {
#define PG8_LAS __attribute__((address_space(3)))
typedef unsigned short bf16_t;
typedef short bf16x8 __attribute__((ext_vector_type(8)));
typedef float f32x4 __attribute__((ext_vector_type(4)));
typedef unsigned u32x4 __attribute__((ext_vector_type(4)));
constexpr int BM = 256, BK = 64, HALF = 128, HTB = HALF * BK * 2  , STAGE_BYTES = 8 * HTB, NXCD = 8, WGM = 8;

__host__ __device__ __forceinline__ int lds_byte(int r, int c) { const int st = (r >> 4) * 2 + (c >> 5), rr = r & 15, cc = c & 31, ob = rr * 64 + cc * 2; return st * 1024 + (ob ^ (((ob >> 9) & 1) << 5)); }
__host__ __device__ __forceinline__ void stage_rc(int b, int& R, int& C) { const int st = b / 1024, sb = b % 1024, swz = sb ^ (((sb >> 9) & 1) << 5); R = (st >> 1) * 16 + swz / 64; C = (st & 1) * 32 + (swz % 64) / 2; }
__host__ __device__ __forceinline__ int perm32(int rho) { const int n = rho >> 4, i = rho & 15; return 8 * (i >> 2) + 4 * n + (i & 3); }

struct Unit { int pm, pn; };
struct Gemm { const bf16_t* A; const bf16_t* Bt; int M, N, K; };

struct StaticOrder {
    int nM, nN, nwg, G, c;
    __host__ __device__ void init(int M, int N, int G_, int c_) { nM = M / BM; nN = N / BM; nwg = nM * nN; G = G_; c = c_; }
    __host__ __device__ bool next(int i, Unit& u) const {
        const long L = (long)i * G + c; if (L >= nwg) return false;
        int wgid = (int)L; { const int q = nwg / NXCD, r = nwg % NXCD, xcd = wgid % NXCD, off = wgid / NXCD; wgid = (xcd < r ? xcd * (q + 1) : r * (q + 1) + (xcd - r) * q) + off; }
        const int nig = WGM * nN, gid = wgid / nig, fm = gid * WGM, gsz = (nM - fm) < WGM ? (nM - fm) : WGM;
        u.pm = fm + ((wgid % nig) % gsz); u.pn = (wgid % nig) / gsz; return true;
    }
    __device__ __forceinline__ void a_ready(const Unit&) const {}
    __device__ __forceinline__ void done(const Unit&) const {}
};

__device__ __forceinline__ unsigned cvt_pk_bf16(float lo, float hi) { unsigned r; asm volatile("v_cvt_pk_bf16_f32 %0, %1, %2" : "=v"(r) : "v"(lo), "v"(hi)); return r; }
typedef float f32x2 __attribute__((ext_vector_type(2)));
__device__ __forceinline__ f32x2 gelu_pk(f32x2 v) {
    const f32x2 av = __builtin_elementwise_abs(v), d = av * 0.2316418882f + 1.0f;
    f32x2 t; t.x = __builtin_amdgcn_rcpf(d.x); t.y = __builtin_amdgcn_rcpf(d.y);
    f32x2 q = t * 0.5307027145f + (-0.7265760135f); q = q * t + 0.7107068705f; q = q * t + (-0.142248368f); q = q * t + 0.127414796f; q = q * t;
    const f32x2 s = (v * v) * (-0.72134752044f);
    f32x2 e; e.x = __builtin_amdgcn_exp2f(s.x); e.y = __builtin_amdgcn_exp2f(s.y);
    const f32x2 m = v * (q * e), r = v - m;
    f32x2 o; o.x = v.x < 0.f ? m.x : r.x; o.y = v.y < 0.f ? m.y : r.y; return o;
}

template <int ACT  > struct EpiBf16 {
    static constexpr bool PERM = true, AFTER_DRAIN = false; static_assert(ACT == 0 || ACT == 1, "EpiBf16: ACT is 0 (none) or 1 (gelu_pk)");
    bf16_t* O; int ldc; const float* bias; int split_cols; size_t split_stride; float scale0;
    __device__ __forceinline__ void operator()(const f32x4 (&acc)[2][2][4][2], const Unit& u, int wr, int wc, int fr, int fq) const {
        const int row0 = u.pm * BM + wr * 64 + fr; int colt = u.pn * BM; bf16_t* base = O;
        float sc = 1.f; if (split_cols) { const int t = colt / split_cols; base += (size_t)t * split_stride; colt -= t * split_cols; if (t == 0) sc = scale0; }
        const int col0 = colt + wc * 32 + 8 * fq, bcol0 = u.pn * BM + wc * 32 + 8 * fq;
        f32x4 bv[2][2];
#pragma unroll
        for (int bj = 0; bj < 2; ++bj)
#pragma unroll
            for (int n = 0; n < 2; ++n) bv[bj][n] = bias ? *(const f32x4*)(bias + bcol0 + bj * HALF + 4 * n) : (f32x4){0.f, 0.f, 0.f, 0.f};
#pragma unroll
        for (int ai = 0; ai < 2; ++ai)
#pragma unroll
            for (int m = 0; m < 4; ++m) { bf16_t* rowp = base + (size_t)(row0 + ai * HALF + m * 16) * ldc + col0;
#pragma unroll
                for (int bj = 0; bj < 2; ++bj) { f32x4 v0 = acc[ai][bj][m][0] + bv[bj][0], v1 = acc[ai][bj][m][1] + bv[bj][1];
                    if (ACT == 1) { f32x2 a = gelu_pk((f32x2){v0[0], v0[1]}), b = gelu_pk((f32x2){v0[2], v0[3]}), c = gelu_pk((f32x2){v1[0], v1[1]}), d = gelu_pk((f32x2){v1[2], v1[3]});
                        v0 = (f32x4){a.x, a.y, b.x, b.y}; v1 = (f32x4){c.x, c.y, d.x, d.y}; }
                    v0 = v0 * sc; v1 = v1 * sc; u32x4 w; w.x = cvt_pk_bf16(v0[0], v0[1]); w.y = cvt_pk_bf16(v0[2], v0[3]); w.z = cvt_pk_bf16(v1[0], v1[1]); w.w = cvt_pk_bf16(v1[2], v1[3]);
                    *(u32x4*)(rowp + bj * HALF) = w; } }
    }
};

struct PanelStats {
    unsigned* xbuf;
    unsigned* cnt;
    unsigned* tmo;
    int ntn; float eps;
    unsigned code;
    __device__ __forceinline__ bool run(const f32x4 (&v)[2][2][4][2], const Unit& u, int wr, int wc, int fr, int fq, PG8_LAS unsigned char* lds, int wid, int lane) const {
        typedef float f32x2v __attribute__((ext_vector_type(2)));
        PG8_LAS f32x2v* P = (PG8_LAS f32x2v*)lds;
        PG8_LAS f32x2v* S = (PG8_LAS f32x2v*)(lds + 8192);
        PG8_LAS unsigned* flag = (PG8_LAS unsigned*)(lds + 8192 + 2048);
#pragma unroll
        for (int ai = 0; ai < 2; ++ai)
#pragma unroll
            for (int m = 0; m < 4; ++m) {
                float s = 0.f;
#pragma unroll
                for (int bj = 0; bj < 2; ++bj)
#pragma unroll
                    for (int n = 0; n < 2; ++n) { const f32x4 x = v[ai][bj][m][n]; s += (x[0] + x[1]) + (x[2] + x[3]); }
                s += __shfl_xor(s, 16); s += __shfl_xor(s, 32);
                const float mw = s * (1.0f / 64.0f); float q = 0.f;
#pragma unroll
                for (int bj = 0; bj < 2; ++bj)
#pragma unroll
                    for (int n = 0; n < 2; ++n) { const f32x4 d = v[ai][bj][m][n] - mw; q += (d[0] * d[0] + d[1] * d[1]) + (d[2] * d[2] + d[3] * d[3]); }
                q += __shfl_xor(q, 16); q += __shfl_xor(q, 32);
                if (fq == 0) P[(ai * HALF + wr * 64 + m * 16 + fr) * 4 + wc] = (f32x2v){mw, q};
            }
        asm volatile("s_waitcnt lgkmcnt(0)" ::: "memory"); __builtin_amdgcn_s_barrier(); asm volatile("" ::: "memory");
#if defined(BROKEN_EXCHANGE_NO_WAIT)
#warning BROKEN CONTROL BUILD: the row-statistics exchange does not wait; results are wrong by design
        if (blockIdx.x >= 64) { const long long t0_ = clock64(); while (clock64() - t0_ < 60000) __builtin_amdgcn_s_sleep(8); }
#endif
        const int row = wid * 32 + (lane & 31);
        if (lane < 32) {
            const f32x2v a = P[row * 4 + 0], b = P[row * 4 + 1], c = P[row * 4 + 2], d = P[row * 4 + 3];
            const float mt = (a.x + b.x + c.x + d.x) * 0.25f;
            const float da = a.x - mt, db = b.x - mt, dc = c.x - mt, dd = d.x - mt;
            const float m2 = (a.y + b.y) + (c.y + d.y) + 64.0f * ((da * da + db * db) + (dc * dc + dd * dd));
            unsigned long long* slot = (unsigned long long*)xbuf + ((size_t)(u.pm * BM + row) * 4 + u.pn);
            __hip_atomic_store(slot, ((unsigned long long)__float_as_uint(m2) << 32) | __float_as_uint(mt), __ATOMIC_RELAXED, __HIP_MEMORY_SCOPE_AGENT);
        }
        asm volatile("s_waitcnt vmcnt(0)" ::: "memory");
        if (lane == 0) __hip_atomic_fetch_add(cnt + 64 * u.pm, 1u, __ATOMIC_RELAXED, __HIP_MEMORY_SCOPE_AGENT);
        if (wid == 0) {
            bool dead = false; const unsigned long long t0 = __builtin_amdgcn_s_memrealtime(); const unsigned want = 8u * (unsigned)ntn;
            for (;;) {
#if defined(BROKEN_EXCHANGE_NO_WAIT)
                break;
#endif
                if ((unsigned)__builtin_amdgcn_readfirstlane(__hip_atomic_load(cnt + 64 * u.pm, __ATOMIC_RELAXED, __HIP_MEMORY_SCOPE_AGENT)) >= want) break;
                if (__builtin_amdgcn_s_memrealtime() - t0 > 2000000ull) {
                    if (lane == 0) { unsigned expect = 0u; __hip_atomic_compare_exchange_strong(tmo + 1, &expect, code | (unsigned)(u.pm & 0xff), __ATOMIC_RELAXED, __ATOMIC_RELAXED, __HIP_MEMORY_SCOPE_AGENT);
                                     __hip_atomic_store(tmo, 1u, __ATOMIC_RELAXED, __HIP_MEMORY_SCOPE_AGENT); }
                    dead = true; break; }
                __builtin_amdgcn_s_sleep(2);
            }
            __builtin_amdgcn_fence(__ATOMIC_ACQUIRE, "agent");
            if (lane == 0) flag[0] = dead ? 1u : 0u;
        }
        asm volatile("s_waitcnt vmcnt(0) lgkmcnt(0)" ::: "memory"); __builtin_amdgcn_s_barrier(); asm volatile("" ::: "memory");
        const bool bad = flag[0] != 0u;
        if (lane < 32) {
            const unsigned long long* slot = (const unsigned long long*)xbuf + (size_t)(u.pm * BM + row) * 4; float mt[4], m2[4]; float ms = 0.f;
#pragma unroll
            for (int t = 0; t < 4; ++t) { if (t < ntn) { const unsigned long long w = __hip_atomic_load(slot + t, __ATOMIC_RELAXED, __HIP_MEMORY_SCOPE_AGENT); mt[t] = __uint_as_float((unsigned)w); m2[t] = __uint_as_float((unsigned)(w >> 32)); } else { mt[t] = 0.f; m2[t] = 0.f; } ms += mt[t]; }
            const float mean = ms / (float)ntn; float q = 0.f;
#pragma unroll
            for (int t = 0; t < 4; ++t) if (t < ntn) { const float dm = mt[t] - mean; q += m2[t] + 256.0f * dm * dm; }
            S[row] = (f32x2v){mean, 1.0f / sqrtf(q / (256.0f * (float)ntn) + eps)};
        }
        asm volatile("s_waitcnt lgkmcnt(0)" ::: "memory"); __builtin_amdgcn_s_barrier(); asm volatile("" ::: "memory");
        return bad;
    }
};
struct EpiLnRes {
    static constexpr bool PERM = false, AFTER_DRAIN = true;
    const float* base; float* out; int ldc; const float* bias; PanelStats st; unsigned poison;
    __device__ __forceinline__ void fused(f32x4 (&acc)[2][2][4][2], const Unit& u, int wr, int wc, int fr, int fq, PG8_LAS unsigned char* lds, int wid, int lane) const {
        typedef float f32x2v __attribute__((ext_vector_type(2)));
        const PG8_LAS f32x2v* S = (const PG8_LAS f32x2v*)(lds + 8192);
        const int col0 = u.pn * BM + wc * 32 + 4 * fq;
#pragma unroll
        for (int bj = 0; bj < 2; ++bj)
#pragma unroll
            for (int n = 0; n < 2; ++n) { const f32x4 bv = bias ? *(const f32x4*)(bias + col0 + bj * HALF + n * 16) : (f32x4){0.f, 0.f, 0.f, 0.f};
#pragma unroll
                for (int ai = 0; ai < 2; ++ai)
#pragma unroll
                    for (int m = 0; m < 4; ++m) acc[ai][bj][m][n] += bv; }
        f32x4 pre[4][2][2];
#pragma unroll
        for (int m = 0; m < 4; ++m) { const size_t off = (size_t)(u.pm * BM + wr * 64 + m * 16 + fr) * ldc + col0;
#pragma unroll
            for (int bj = 0; bj < 2; ++bj)
#pragma unroll
                for (int n = 0; n < 2; ++n) pre[m][bj][n] = *(const f32x4*)(base + off + bj * HALF + n * 16); }
        const bool bad = st.run(acc, u, wr, wc, fr, fq, lds, wid, lane) || poison != 0u;
        const float qnan = __builtin_nanf("");
#pragma unroll
        for (int ai = 0; ai < 2; ++ai)
#pragma unroll
            for (int m = 0; m < 4; ++m) { const int r = ai * HALF + wr * 64 + m * 16 + fr; const f32x2v sr = S[r]; const size_t off = (size_t)(u.pm * BM + r) * ldc + col0;
#pragma unroll
                for (int bj = 0; bj < 2; ++bj)
#pragma unroll
                    for (int n = 0; n < 2; ++n) { const f32x4 bs = ai == 0 ? pre[m][bj][n] : *(const f32x4*)(base + off + bj * HALF + n * 16); f32x4 o = bs + (acc[ai][bj][m][n] - sr.x) * sr.y;
                        if (bad) o = (f32x4){qnan, qnan, qnan, qnan}; *(f32x4*)(out + off + bj * HALF + n * 16) = o; }
                if (m & 1) asm volatile("" ::: "memory"); }
    }
};
struct EpiLnResLn {
    static constexpr bool PERM = false, AFTER_DRAIN = true;
    const float* base; float* out; bf16_t* xn; int ldc; const float* bias; PanelStats st1, st2; unsigned poison;
    __device__ __forceinline__ void fused(f32x4 (&acc)[2][2][4][2], const Unit& u, int wr, int wc, int fr, int fq, PG8_LAS unsigned char* lds, int wid, int lane) const {
        typedef float f32x2v __attribute__((ext_vector_type(2))); typedef unsigned u32x2v __attribute__((ext_vector_type(2)));
        const PG8_LAS f32x2v* S = (const PG8_LAS f32x2v*)(lds + 8192);
        const int col0 = u.pn * BM + wc * 32 + 4 * fq;
#pragma unroll
        for (int bj = 0; bj < 2; ++bj)
#pragma unroll
            for (int n = 0; n < 2; ++n) { const f32x4 bv = bias ? *(const f32x4*)(bias + col0 + bj * HALF + n * 16) : (f32x4){0.f, 0.f, 0.f, 0.f};
#pragma unroll
                for (int ai = 0; ai < 2; ++ai)
#pragma unroll
                    for (int m = 0; m < 4; ++m) acc[ai][bj][m][n] += bv; }
        bool bad = st1.run(acc, u, wr, wc, fr, fq, lds, wid, lane) || poison != 0u;
        const float qnan = __builtin_nanf("");
#pragma unroll
        for (int ai = 0; ai < 2; ++ai)
#pragma unroll
            for (int m = 0; m < 4; ++m) { const int r = ai * HALF + wr * 64 + m * 16 + fr; const f32x2v sr = S[r]; const size_t off = (size_t)(u.pm * BM + r) * ldc + col0;
#pragma unroll
                for (int bj = 0; bj < 2; ++bj)
#pragma unroll
                    for (int n = 0; n < 2; ++n) { const f32x4 bs = *(const f32x4*)(base + off + bj * HALF + n * 16); acc[ai][bj][m][n] = bs + (acc[ai][bj][m][n] - sr.x) * sr.y; }
                asm volatile("" : "+v"(acc[ai][0][m][0]), "+v"(acc[ai][0][m][1]), "+v"(acc[ai][1][m][0]), "+v"(acc[ai][1][m][1]));
                if (m & 1) asm volatile("" ::: "memory"); }
        const bool bad1 = bad;
        bad = st2.run(acc, u, wr, wc, fr, fq, lds, wid, lane) || bad;
#pragma unroll
        for (int ai = 0; ai < 2; ++ai)
#pragma unroll
            for (int m = 0; m < 4; ++m) { const int r = ai * HALF + wr * 64 + m * 16 + fr; const f32x2v sr = S[r]; const size_t off = (size_t)(u.pm * BM + r) * ldc + col0;
#pragma unroll
                for (int bj = 0; bj < 2; ++bj)
#pragma unroll
                    for (int n = 0; n < 2; ++n) { const f32x4 x1 = acc[ai][bj][m][n]; *(f32x4*)(out + off + bj * HALF + n * 16) = bad1 ? (f32x4){qnan, qnan, qnan, qnan} : x1;
                        const f32x4 o = (x1 - sr.x) * sr.y; u32x2v w; w.x = cvt_pk_bf16(o[0], o[1]); w.y = cvt_pk_bf16(o[2], o[3]);
                        if (bad) { w.x = 0x7fc07fc0u; w.y = 0x7fc07fc0u; } *(u32x2v*)(xn + off + bj * HALF + n * 16) = w; }
                asm volatile("" ::: "memory"); }
    }
};

template <class Epi, class Sched, bool ALIGN_EPI = false, bool SP2 = false>
__device__ __forceinline__ void gemm_phase(PG8_LAS unsigned char* lds, const Gemm g, const Sched& S, const Epi& E) {
    const int tid = threadIdx.x, wid = __builtin_amdgcn_readfirstlane(tid >> 6), lane = tid & 63, wr = wid >> 2, wc = wid & 3, fr = lane & 15, fq = lane >> 4;
    const int K = g.K, nt = K / BK;
    unsigned voffA[2], voffB[2];
#pragma unroll
    for (int i = 0; i < 2; ++i) { int R, C; stage_rc(tid * 16 + i * 8192, R, C); const int Rb = Epi::PERM ? ((R & ~31) + perm32(R & 31)) : R;
        voffA[i] = (unsigned)(R * K + C) * 2u; voffB[i] = (unsigned)(Rb * K + C) * 2u; }
    const size_t kstep = (size_t)(BK * 2);
    const size_t hstep = (size_t)HALF * K * 2;
    const size_t tstep = 2 * hstep;
    const unsigned ldsw = (unsigned)wid * 1024u;
    const int aoff = lds_byte(wr * 64 + fr, fq * 8), boff = lds_byte(wc * 32 + fr, fq * 8);
#define PG8_SA(b, h) (((b) * 2 + (h)) * HTB)
#define PG8_SB(b, h) ((4 + (b) * 2 + (h)) * HTB)
#define PG8_STAGE(bufoff, gbase, voff) do { _Pragma("unroll") for (int _i = 0; _i < 2; ++_i) \
        __builtin_amdgcn_global_load_lds((const unsigned*)((const char*)(gbase) + (voff)[_i]), (PG8_LAS unsigned*)(lds + (bufoff) + ldsw + _i * 8192), 16, 0, 0); } while (0)
#define PG8_LDA(dst, b, h) do { _Pragma("unroll") for (int m = 0; m < 4; ++m) _Pragma("unroll") for (int k = 0; k < 2; ++k) dst[m][k] = *(const PG8_LAS bf16x8*)(lds + PG8_SA(b, h) + aoff + m * 2048 + k * 1024); } while (0)
#define PG8_LDB(dst, b, h) do { _Pragma("unroll") for (int n = 0; n < 2; ++n) _Pragma("unroll") for (int k = 0; k < 2; ++k) dst[n][k] = *(const PG8_LAS bf16x8*)(lds + PG8_SB(b, h) + boff + n * 2048 + k * 1024); } while (0)
#define PG8_MMA(ai, bj, At, Bt) do { __builtin_amdgcn_s_setprio(1); _Pragma("unroll") for (int m = 0; m < 4; ++m) _Pragma("unroll") for (int n = 0; n < 2; ++n) _Pragma("unroll") for (int k = 0; k < 2; ++k) \
        acc[ai][bj][m][n] = __builtin_amdgcn_mfma_f32_16x16x32_bf16(Bt[n][k], At[m][k], acc[ai][bj][m][n], 0, 0, 0); __builtin_amdgcn_s_setprio(0); } while (0)
#define PG8_WAIT_V(n) asm volatile("s_waitcnt vmcnt(" #n ")" ::: "memory")
#define PG8_WAIT_L(n) asm volatile("s_waitcnt lgkmcnt(" #n ")" ::: "memory")
#define PG8_BAR __builtin_amdgcn_s_barrier()
#define PG8_SCHED __builtin_amdgcn_sched_barrier(0)
    Unit cur, nxt; int ui = 0;
    if (!S.next(0, cur)) return;
    f32x4 acc[2][2][4][2];
#pragma unroll
    for (int a = 0; a < 2; ++a)
#pragma unroll
        for (int b = 0; b < 2; ++b)
#pragma unroll
            for (int m = 0; m < 4; ++m)
#pragma unroll
                for (int n = 0; n < 2; ++n) acc[a][b][m][n] = (f32x4){0.f, 0.f, 0.f, 0.f};
    bf16x8 At[4][2], B0[2][2], B1[2][2];
    const char* cA = (const char*)g.A + (size_t)cur.pm * tstep; const char* cB = (const char*)g.Bt + (size_t)cur.pn * tstep;
    S.a_ready(cur);
    if constexpr (SP2) {
        PG8_STAGE(PG8_SB(0, 0), cB, voffB); PG8_STAGE(PG8_SB(0, 1), cB + hstep, voffB); PG8_STAGE(PG8_SA(0, 0), cA, voffA); PG8_STAGE(PG8_SA(0, 1), cA + hstep, voffA);
        if (wr == 1) PG8_BAR;
        PG8_WAIT_V(2); PG8_BAR;
        PG8_STAGE(PG8_SB(1, 0), cB + kstep, voffB); PG8_STAGE(PG8_SA(1, 0), cA + kstep, voffA); PG8_STAGE(PG8_SB(1, 1), cB + hstep + kstep, voffB);
        PG8_WAIT_V(6); PG8_BAR;
    } else {
        PG8_STAGE(PG8_SB(0, 0), cB, voffB); PG8_STAGE(PG8_SA(0, 0), cA, voffA); PG8_STAGE(PG8_SB(0, 1), cB + hstep, voffB); PG8_STAGE(PG8_SA(0, 1), cA + hstep, voffA);
        if (wr == 1) PG8_BAR;
        PG8_WAIT_V(4); PG8_BAR;
        PG8_STAGE(PG8_SB(1, 0), cB + kstep, voffB); PG8_STAGE(PG8_SA(1, 0), cA + kstep, voffA); PG8_STAGE(PG8_SB(1, 1), cB + hstep + kstep, voffB);
        PG8_WAIT_V(6); PG8_BAR;
    }
    for (;;) {
        const bool has_next = S.next(ui + 1, nxt);
        const char* nA = has_next ? (const char*)g.A + (size_t)nxt.pm * tstep : cA; const char* nB = has_next ? (const char*)g.Bt + (size_t)nxt.pn * tstep : cB;
        for (int t = 0; t < nt; t += 2) {
            const bool last = (t == nt - 2);
            const char* a1 = cA + (size_t)(t + 1) * kstep;
            const char* a2 = last ? nA : cA + (size_t)(t + 2) * kstep; const char* b2 = last ? nB : cB + (size_t)(t + 2) * kstep;
            const char* a3 = a2 + kstep; const char* b3 = b2 + kstep;
            if (last && has_next) S.a_ready(nxt);
            if constexpr (SP2) {
            PG8_LDB(B0, 0, 0); PG8_LDB(B1, 0, 1); PG8_SCHED; PG8_LDA(At, 0, 0); PG8_STAGE(PG8_SA(1, 1), a1 + hstep, voffA);
            PG8_WAIT_V(8); PG8_WAIT_L(0); PG8_BAR; PG8_MMA(0, 0, At, B0); PG8_MMA(0, 1, At, B1); PG8_BAR; PG8_SCHED;
            PG8_LDA(At, 0, 1); PG8_STAGE(PG8_SB(0, 0), b2, voffB); PG8_STAGE(PG8_SB(0, 1), b2 + hstep, voffB); PG8_STAGE(PG8_SA(0, 0), a2, voffA);
            PG8_WAIT_V(8); PG8_WAIT_L(0); PG8_BAR; PG8_MMA(1, 0, At, B0); PG8_MMA(1, 1, At, B1); PG8_BAR; PG8_SCHED;
            PG8_LDB(B0, 1, 0); PG8_LDB(B1, 1, 1); PG8_SCHED; PG8_LDA(At, 1, 0); PG8_STAGE(PG8_SA(0, 1), a2 + hstep, voffA);
            PG8_WAIT_V(8); PG8_WAIT_L(0); PG8_BAR; PG8_MMA(0, 0, At, B0); PG8_MMA(0, 1, At, B1); PG8_BAR; PG8_SCHED;
            PG8_LDA(At, 1, 1); PG8_STAGE(PG8_SB(1, 0), b3, voffB); PG8_STAGE(PG8_SB(1, 1), b3 + hstep, voffB); PG8_STAGE(PG8_SA(1, 0), a3, voffA);
            PG8_WAIT_V(8); PG8_WAIT_L(0); PG8_BAR; PG8_MMA(1, 0, At, B0); PG8_MMA(1, 1, At, B1); PG8_BAR; PG8_SCHED;
            } else {
            PG8_LDB(B0, 0, 0); PG8_SCHED; PG8_LDA(At, 0, 0); PG8_STAGE(PG8_SA(1, 1), a1 + hstep, voffA);
            PG8_WAIT_L(8); PG8_BAR; PG8_WAIT_L(0); PG8_MMA(0, 0, At, B0); PG8_BAR; PG8_SCHED;
            PG8_LDB(B1, 0, 1); PG8_STAGE(PG8_SB(0, 0), b2, voffB);
            PG8_BAR; PG8_WAIT_L(0); PG8_MMA(0, 1, At, B1); PG8_BAR;
            PG8_LDA(At, 0, 1); PG8_STAGE(PG8_SA(0, 0), a2, voffA);
            PG8_BAR; PG8_WAIT_L(0); PG8_MMA(1, 0, At, B0); PG8_BAR; PG8_SCHED;
            PG8_STAGE(PG8_SB(0, 1), b2 + hstep, voffB);
            PG8_WAIT_V(6); PG8_BAR; PG8_MMA(1, 1, At, B1); PG8_BAR;
            PG8_LDB(B0, 1, 0); PG8_SCHED; PG8_LDA(At, 1, 0); PG8_STAGE(PG8_SA(0, 1), a2 + hstep, voffA);
            PG8_WAIT_L(8); PG8_BAR; PG8_WAIT_L(0); PG8_MMA(0, 0, At, B0); PG8_BAR; PG8_SCHED;
            PG8_LDB(B1, 1, 1); PG8_STAGE(PG8_SB(1, 0), b3, voffB);
            PG8_BAR; PG8_WAIT_L(0); PG8_MMA(0, 1, At, B1); PG8_BAR;
            PG8_LDA(At, 1, 1); PG8_STAGE(PG8_SA(1, 0), a3, voffA);
            PG8_BAR; PG8_WAIT_L(0); PG8_MMA(1, 0, At, B0); PG8_BAR; PG8_SCHED;
            PG8_STAGE(PG8_SB(1, 1), b3 + hstep, voffB);
            PG8_WAIT_V(6); PG8_BAR; PG8_MMA(1, 1, At, B1); PG8_BAR;
            }
        }
        if constexpr (ALIGN_EPI) { if (wr == 0) PG8_BAR; }
        if constexpr (!Epi::AFTER_DRAIN) { E(acc, cur, wr, wc, fr, fq); S.done(cur); }
        if (!has_next) break;
#pragma unroll
        for (int a = 0; a < 2; ++a)
#pragma unroll
            for (int b = 0; b < 2; ++b)
#pragma unroll
                for (int m = 0; m < 4; ++m)
#pragma unroll
                    for (int n = 0; n < 2; ++n) acc[a][b][m][n] = (f32x4){0.f, 0.f, 0.f, 0.f};
        cur = nxt; cA = nA; cB = nB; ++ui;
        if constexpr (ALIGN_EPI) { if (wr == 1) PG8_BAR; }
    }
    PG8_WAIT_V(0);
    if constexpr (!ALIGN_EPI) { if (wr == 0) PG8_BAR; }
    PG8_BAR;
    if constexpr (Epi::AFTER_DRAIN) { E.fused(acc, cur, wr, wc, fr, fq, lds, wid, lane); S.done(cur); }
#undef PG8_SA
#undef PG8_SB
#undef PG8_STAGE
#undef PG8_LDA
#undef PG8_LDB
#undef PG8_MMA
#undef PG8_WAIT_V
#undef PG8_WAIT_L
#undef PG8_BAR
#undef PG8_SCHED
}
}
#ifndef PG8_SP2
#define PG8_SP2 true
#endif
#ifndef PG8_ALIGN
#define PG8_ALIGN true
#endif
#define GAS __attribute__((address_space(1)))
#define LAS __attribute__((address_space(3)))
typedef unsigned short bf16;
typedef unsigned v4u __attribute__((ext_vector_type(4)));
typedef float f32x4 __attribute__((ext_vector_type(4)));
typedef short bf16x8 __attribute__((ext_vector_type(8)));
typedef GAS unsigned gu32;
typedef GAS unsigned long long gu64;
#define RLX_AGENT __ATOMIC_RELAXED, __HIP_MEMORY_SCOPE_AGENT
#define LDS_WAIT() asm volatile("s_waitcnt lgkmcnt(0)" ::: "memory")
#define VM_WAIT() asm volatile("s_waitcnt vmcnt(0)" ::: "memory")
__device__ __forceinline__ unsigned long long rt() { return __builtin_amdgcn_s_memrealtime(); }
__device__ __forceinline__ unsigned f2bf(float f) { unsigned u = __builtin_bit_cast(unsigned, f); return (u + 0x7fffu + ((u >> 16) & 1u)) >> 16; }
__device__ __forceinline__ unsigned pk2(float lo, float hi) { return f2bf(lo) | (f2bf(hi) << 16); }

#define XB_TMO      128
#define XB_XCNT(j)  (256  + 64 * (j))
#define XB_XSUB(j)  (1280 + 64 * (j))
#define XB_XGEN(j)  (2304 + 64 * (j))
#define XB_TOP      3328
#define XB_TOPGEN   3392
#define XCD_BAR_WORDS 3456
#define XB_SPIN_CAP (1u << 18)

__device__ __forceinline__ unsigned xb_ld(unsigned* p)              { return __hip_atomic_load(p, __ATOMIC_RELAXED, __HIP_MEMORY_SCOPE_AGENT); }
__device__ __forceinline__ unsigned xb_add(unsigned* p, unsigned v) { return __hip_atomic_fetch_add(p, v, __ATOMIC_RELAXED, __HIP_MEMORY_SCOPE_AGENT); }
__device__ __forceinline__ unsigned xb_xcc_id() { return (unsigned)__builtin_amdgcn_s_getreg((3 << 11) | 20) & 0xFu; }
#define XB_SPIN(cond, bar) do { unsigned _sp = 0; while (cond) { __builtin_amdgcn_s_sleep(1); \
    if ((++_sp & 255u) == 0u) { if (xb_ld(&(bar)[XB_TMO])) break; if (_sp > XB_SPIN_CAP) { atomicAdd(&(bar)[XB_TMO], 1u); break; } } } } while (0)

struct XcdBarrier {
    unsigned* bar; unsigned x;
    volatile LAS unsigned* st;
};

__device__ __forceinline__ XcdBarrier xcd_barrier_post(unsigned* bar, volatile LAS unsigned* st) {
    XcdBarrier b; b.bar = bar; b.x = xb_xcc_id(); b.st = st;
    if (threadIdx.x == 0) (void)xb_add(&bar[XB_XCNT(b.x)], 1u);
    return b;
}
__device__ __forceinline__ void xcd_barrier_complete(unsigned* bar, unsigned x, unsigned& nloc, unsigned& nx) {
    const unsigned G = gridDim.x * gridDim.y * gridDim.z;
    unsigned sum, cnt, mine, sp = 0u;
    for (;;) {
        sum = 0u; cnt = 0u; mine = 0u;
#pragma unroll
        for (unsigned j = 0; j < 16; ++j) { const unsigned c = xb_ld(&bar[XB_XCNT(j)]); sum += c; cnt += (c > 0u) ? 1u : 0u; mine = (j == x) ? c : mine; }
        if (sum == G) break;
        __builtin_amdgcn_s_sleep(1);
        if ((++sp & 255u) == 0u) { if (xb_ld(&bar[XB_TMO])) break; if (sp > XB_SPIN_CAP) { atomicAdd(&bar[XB_TMO], 1u); break; } }
    }
    nloc = mine > 0u ? mine : 1u; nx = cnt > 0u ? cnt : 1u;
}

__device__ __forceinline__ void xcd_barrier(const XcdBarrier& b) {
    asm volatile("s_waitcnt vmcnt(0)" ::: "memory");
    __syncthreads();
    if (threadIdx.x == 0) {
        unsigned* bar = b.bar;
        __builtin_amdgcn_s_waitcnt(0);
        unsigned nloc = b.st[0], nx = b.st[1];
        if (nloc == 0u) { xcd_barrier_complete(bar, b.x, nloc, nx); b.st[0] = nloc; b.st[1] = nx; }
        const unsigned old = xb_add(&bar[XB_XSUB(b.x)], 1u);
        const unsigned gen = old / nloc;
        if (old + 1u == (gen + 1u) * nloc) {
            __builtin_amdgcn_fence(__ATOMIC_RELEASE, "agent");
            asm volatile("s_waitcnt vmcnt(0)" ::: "memory");
            const unsigned og = xb_add(&bar[XB_TOP], 1u);
            const unsigned tg = og / nx;
            if (og + 1u == (tg + 1u) * nx) xb_add(&bar[XB_TOPGEN], 1u);
            else XB_SPIN(xb_ld(&bar[XB_TOPGEN]) == tg, bar);
            __builtin_amdgcn_fence(__ATOMIC_ACQUIRE, "agent");
            xb_add(&bar[XB_XGEN(b.x)], 1u);
            asm volatile("s_waitcnt vmcnt(0)" ::: "memory");
        } else {
            XB_SPIN(xb_ld(&bar[XB_XGEN(b.x)]) == gen, bar);
            __builtin_amdgcn_fence(__ATOMIC_ACQUIRE, "agent");
            asm volatile("s_waitcnt vmcnt(0)" ::: "memory");
        }
    }
    __syncthreads();
}
constexpr int NWAVES = 8, NTHREADS = 512;
constexpr int DM = 1024, SEQ = 8192, MP = 16384, NS = 128, MT = 16640;
constexpr int FF = 2816, FF2 = 5632, NMOD = 14336, NIN = 3072, LDW_IN = 3080;
constexpr int QW = 1536;
constexpr float EPSN = 1e-6f;
constexpr float LOG2E = 1.4426950408889634f;
constexpr float ATT_C2 = 0.10206207261596577f * 1.4426950408889634f;
constexpr float QK_SCALE = 0.08838834764831845f;
constexpr size_t O_YP = 0, O_YS = 16777216, O_CP = 16908288, O_NP = 17170432, O_MP = 17171456, O_CONVP = 17171464, O_CKVP = 17193992, O_KPEP = 21388296,
                 O_CS = 21912584, O_NS = 38689800, O_MS = 38755336, O_CONVS = 38755848, O_CKVS = 40197640, O_KPES = 40230408, O_END = 40234504;

constexpr size_t al256(size_t x) { return (x + 255) & ~(size_t)255; }
constexpr size_t WS_CTL = 0, CTL_ZERO_BYTES = 1u << 20;
constexpr size_t WS_WIN   = WS_CTL + CTL_ZERO_BYTES;
constexpr size_t WS_WOUT  = WS_WIN + (size_t)NIN * DM * 2;
constexpr size_t WS_WUP   = WS_WOUT + (size_t)DM * DM * 2;
constexpr size_t WS_WDOWN = WS_WUP + 2 * (size_t)FF2 * DM * 2;
constexpr size_t WS_WDKV  = WS_WDOWN + 2 * (size_t)DM * FF * 2;
constexpr size_t WS_WDQ   = WS_WDKV + (size_t)512 * DM * 2;
constexpr size_t WS_WUQ   = WS_WDQ + (size_t)512 * DM * 2;
constexpr size_t WS_WKV   = WS_WUQ + (size_t)QW * 384 * 2;
constexpr size_t WS_WO    = WS_WKV + (size_t)2048 * 256 * 2;
constexpr size_t WS_WMOD  = WS_WO + (size_t)DM * DM * 2;
constexpr size_t WS_AMOD  = WS_WMOD + (size_t)NMOD * DM * 2;
constexpr size_t WS_MOD   = WS_AMOD + (size_t)256 * DM * 2;
constexpr size_t WS_ROPE  = WS_MOD + (size_t)256 * NMOD * 4;
constexpr size_t WS_X     = al256(WS_ROPE + (size_t)8193 * 32 * 4);
constexpr size_t WS_XN    = WS_X + (size_t)MT * DM * 4;
constexpr size_t WS_XN2   = WS_XN + (size_t)MT * DM * 2;
constexpr size_t WS_QKVO  = WS_XN2 + (size_t)MT * DM * 2;
constexpr size_t WS_GATES = WS_QKVO + (size_t)MT * NIN * 2;
constexpr size_t WS_CT    = al256(WS_GATES + (size_t)MT * 8 * 4);
constexpr size_t WS_NL    = WS_CT + (size_t)8 * 128 * 256 * 128 * 2;
constexpr size_t WS_CHK   = WS_NL + (size_t)8 * 128 * 128 * 4;
constexpr size_t WS_AG    = al256(WS_CHK + 3 * 1024 * 4);
constexpr size_t WS_U     = WS_AG + (size_t)MT * FF2 * 2;
constexpr size_t WS_LAT   = WS_U + (size_t)MT * FF * 2;
constexpr size_t WS_QLAT  = WS_LAT + (size_t)MT * 512 * 4;
constexpr size_t WS_CKV   = WS_QLAT + (size_t)MT * 512 * 4;
constexpr size_t WS_KPE   = WS_CKV + (size_t)MT * 256 * 2;
constexpr size_t WS_QN    = WS_KPE + (size_t)MT * 32 * 2;
constexpr size_t WS_Q     = WS_QN + (size_t)MT * 384 * 2;
constexpr size_t WS_KN    = WS_Q + (size_t)MT * QW * 2;
constexpr size_t WS_V     = WS_KN + (size_t)MT * DM * 2;
constexpr size_t WS_PART  = WS_V + (size_t)MT * DM * 2;
constexpr size_t WS_QLS   = WS_PART + (size_t)256 * (4096 + 32) * 4;
constexpr size_t WS_HALO  = al256(WS_QLS + (size_t)128 * 16 * 288 * 2);
constexpr size_t WS_FIXA  = WS_HALO + (size_t)512 * FF * 2;
constexpr size_t WS_FIXG  = WS_FIXA + (size_t)512 * FF * 2;
constexpr size_t WS_END   = al256(WS_FIXG + (size_t)512 * FF * 2);
constexpr int CW_BAR = 4096;

constexpr int RING_OFF = 0, RING_BYTES = 131072;
constexpr int LDSCTL_OFF = RING_BYTES, MISC_OFF = LDSCTL_OFF + 320;
constexpr int LDS_BYTES = 147456;

struct Params {
    const float *x_p, *x_s, *st_C, *st_n, *st_m, *st_conv, *cache_ckv, *cache_kpe; const int* page_table;
    const float *c_p, *c_s, *g_norm1, *g_norm2, *w_ada, *b_ada, *w_up, *w_conv, *b_conv, *w_down, *w_m_in, *b_m_gates, *g_m_head, *w_m_out,
                *g_kv_in, *w_ada_kv, *b_ada_kv, *w_dkv, *g_kv, *w_uk, *w_uv, *w_dq, *g_q, *w_uq, *w_o, *g_final;
    float* out; unsigned char* ws; int ph_lo, ph_hi;
};

typedef unsigned u32x2 __attribute__((ext_vector_type(2)));
typedef float f32x2 __attribute__((ext_vector_type(2)));
typedef short s16x4 __attribute__((ext_vector_type(4)));
typedef float f32x16 __attribute__((ext_vector_type(16)));
typedef __bf16 bf16x2_t __attribute__((ext_vector_type(2)));

__device__ __forceinline__ unsigned cvtpk(float lo, float hi) { f32x2 v = {lo, hi}; bf16x2_t b = __builtin_convertvector(v, bf16x2_t); return __builtin_bit_cast(unsigned, b); }
__device__ __forceinline__ float bf_lo(unsigned u) { return __uint_as_float(u << 16); }
__device__ __forceinline__ float bf_hi(unsigned u) { return __uint_as_float(u & 0xffff0000u); }
__device__ __forceinline__ float bf2f(bf16 b) { return __uint_as_float((unsigned)b << 16); }
__device__ __forceinline__ float wave_sum(float v) {
#pragma unroll
    for (int o = 1; o < 64; o <<= 1) v += __shfl_xor(v, o);
    return v;
}
__device__ __forceinline__ float wave_max(float v) {
#pragma unroll
    for (int o = 1; o < 64; o <<= 1) v = fmaxf(v, __shfl_xor(v, o));
    return v;
}
__device__ __forceinline__ float wave_scan_add(float v, int lane) {
#pragma unroll
    for (int o = 1; o < 64; o <<= 1) { const float t = __shfl_up(v, o); if (lane >= o) v += t; }
    return v;
}
__device__ __forceinline__ float wave_scan_max(float v, int lane) {
#pragma unroll
    for (int o = 1; o < 64; o <<= 1) { const float t = __shfl_up(v, o); if (lane >= o) v = fmaxf(v, t); }
    return v;
}
__device__ __forceinline__ float sigmoidf_(float x) { return 1.0f / (1.0f + __expf(-x)); }
__device__ __forceinline__ float siluf_(float x) { return x / (1.0f + __expf(-x)); }
__device__ __forceinline__ float log_sigmoidf_(float x) { return x >= 0.f ? -log1pf(__expf(-x)) : x - log1pf(__expf(x)); }
__device__ __forceinline__ int mrow_of(int r) { return r < MP ? 128 + (r >> 13) : (r < MP + NS ? r - MP : 255); }
__device__ __forceinline__ int pos_of(int r) { return r < MP ? (r & (SEQ - 1)) : SEQ; }

struct Ctx {
    LAS unsigned char* lds; int tid, lane, wave, vcu, G, gw, NGW;
};

struct EpiMod {
    static constexpr bool PERM = false, AFTER_DRAIN = false;
    float* O; const float* b_ada; const float* b_kv;
    __device__ __forceinline__ void operator()(const pg8::f32x4 (&acc)[2][2][4][2], const pg8::Unit& u, int wr, int wc, int fr, int fq) const {
        const int row0 = u.pm * 256 + wr * 64 + fr, col0 = u.pn * 256 + wc * 32 + 4 * fq;
        const float* bp = (u.pn * 256 < 12288) ? b_ada : (b_kv - 12288);
#pragma unroll
        for (int bj = 0; bj < 2; ++bj)
#pragma unroll
            for (int n = 0; n < 2; ++n) { const int col = col0 + bj * 128 + n * 16; const pg8::f32x4 bv = *(const pg8::f32x4*)(bp + col);
#pragma unroll
                for (int ai = 0; ai < 2; ++ai)
#pragma unroll
                    for (int m = 0; m < 4; ++m) { const int row = row0 + ai * 128 + m * 16; *(pg8::f32x4*)(O + (size_t)row * NMOD + col) = acc[ai][bj][m][n] + bv; } }
    }
};
struct EpiF32 {
    static constexpr bool PERM = false, AFTER_DRAIN = false;
    float* O; int ldc;
    __device__ __forceinline__ void operator()(const pg8::f32x4 (&acc)[2][2][4][2], const pg8::Unit& u, int wr, int wc, int fr, int fq) const {
        const int row0 = u.pm * 256 + wr * 64 + fr, col0 = u.pn * 256 + wc * 32 + 4 * fq;
#pragma unroll
        for (int ai = 0; ai < 2; ++ai)
#pragma unroll
            for (int m = 0; m < 4; ++m) { const int row = row0 + ai * 128 + m * 16;
#pragma unroll
                for (int bj = 0; bj < 2; ++bj)
#pragma unroll
                    for (int n = 0; n < 2; ++n) *(pg8::f32x4*)(O + (size_t)row * ldc + col0 + bj * 128 + n * 16) = acc[ai][bj][m][n]; }
    }
};
struct EpiRes {
    static constexpr bool PERM = false, AFTER_DRAIN = false;
    float* X; const float* gate;
    __device__ __forceinline__ void operator()(const pg8::f32x4 (&acc)[2][2][4][2], const pg8::Unit& u, int wr, int wc, int fr, int fq) const {
        const int row0 = u.pm * 256 + wr * 64 + fr, col0 = u.pn * 256 + wc * 32 + 4 * fq;
#pragma unroll
        for (int ai = 0; ai < 2; ++ai)
#pragma unroll
            for (int m = 0; m < 4; ++m) { const int row = row0 + ai * 128 + m * 16; const float* gp = gate + (size_t)mrow_of(row) * NMOD; float* xp = X + (size_t)row * DM;
#pragma unroll
                for (int bj = 0; bj < 2; ++bj)
#pragma unroll
                    for (int n = 0; n < 2; ++n) { const int col = col0 + bj * 128 + n * 16; const pg8::f32x4 gv = *(const pg8::f32x4*)(gp + col); const pg8::f32x4 xv = *(const pg8::f32x4*)(xp + col);
                        *(pg8::f32x4*)(xp + col) = xv + gv * acc[ai][bj][m][n]; }
                if (m & 1) asm volatile("" ::: "memory"); }
    }
};
struct EpiRope {
    static constexpr bool PERM = false, AFTER_DRAIN = false;
    bf16* Q; const float* tab;
    __device__ __forceinline__ void operator()(const pg8::f32x4 (&acc)[2][2][4][2], const pg8::Unit& u, int wr, int wc, int fr, int fq) const {
        const int row0 = u.pm * 256 + wr * 64 + fr, col0 = u.pn * 256 + wc * 32 + 4 * fq;
#pragma unroll
        for (int ai = 0; ai < 2; ++ai)
#pragma unroll
            for (int m = 0; m < 4; ++m) { const int row = row0 + ai * 128 + m * 16; const int pos = pos_of(row);
#pragma unroll
                for (int bj = 0; bj < 2; ++bj) { const int g = 8 * u.pn + 4 * bj + wc; pg8::f32x4 x1 = acc[ai][bj][m][0], x2 = acc[ai][bj][m][1];
                    if (g % 3 == 2) { const pg8::f32x4 c = *(const pg8::f32x4*)(tab + pos * 16 + 4 * fq), s = *(const pg8::f32x4*)(tab + 8193 * 16 + pos * 16 + 4 * fq);
                        const pg8::f32x4 o1 = x1 * c - x2 * s, o2 = x1 * s + x2 * c; x1 = o1; x2 = o2; }
                    bf16* qp = Q + (size_t)row * QW + col0 + bj * 128;
                    u32x2 w1; w1.x = cvtpk(x1[0], x1[1]); w1.y = cvtpk(x1[2], x1[3]); *(u32x2*)qp = w1;
                    u32x2 w2; w2.x = cvtpk(x2[0], x2[1]); w2.y = cvtpk(x2[2], x2[3]); *(u32x2*)(qp + 16) = w2; }
                asm volatile("" ::: "memory"); }
    }
};
__device__ __forceinline__ void tr_item(const float* W, int ldw, int nblk, int K, bf16* WT, int row_off, float scale, LAS float* scr, int item, int lane) {
    const int kb = item / nblk, nb = item % nblk, k0 = 64 * kb, n0 = 32 * nb;
#pragma unroll 8
    for (int i = 0; i < 32; ++i) { const int kk = 2 * i + (lane >> 5); scr[kk * 33 + (lane & 31)] = W[(size_t)(k0 + kk) * ldw + n0 + (lane & 31)] * scale; }
    LDS_WAIT(); asm volatile("" ::: "memory");
    const int c = lane & 7;
#pragma unroll
    for (int j = 0; j < 4; ++j) { const int n = (lane >> 3) + 8 * j; const LAS float* s = scr + (8 * c) * 33 + n;
        v4u o; o.x = cvtpk(s[0 * 33], s[1 * 33]); o.y = cvtpk(s[2 * 33], s[3 * 33]); o.z = cvtpk(s[4 * 33], s[5 * 33]); o.w = cvtpk(s[6 * 33], s[7 * 33]);
        *(GAS v4u*)(WT + (size_t)(row_off + n0 + n) * K + k0 + 8 * c) = o; }
    LDS_WAIT(); asm volatile("" ::: "memory");
}
__device__ __forceinline__ void p0_prologue(const Params& P, const Ctx& C) {
    unsigned char* ws = P.ws;
    LAS float* scr = (LAS float*)(C.lds + RING_OFF + C.wave * 16384);
    constexpr int I_IN = 16 * 96, I_OUT = 16 * 32, I_UP = 16 * 176, I_DOWN = 44 * 32, I_DKV = 16 * 9, I_DQ = 16 * 12, I_UQ = 6 * 48, I_UK = 4 * 32, I_O = 16 * 32, I_ADA = 16 * 192, I_ADAKV = 16 * 64;
    constexpr int NITEMS = I_IN + I_OUT + 2 * I_UP + 2 * I_DOWN + I_DKV + I_DQ + I_UQ + 2 * I_UK + I_O + 2 * I_ADA + I_ADAKV;
    for (int it = C.gw; it < NITEMS; it += C.NGW) {
        int r = it;
        if (r < I_IN) { const int nb = r % 96; tr_item(P.w_m_in, LDW_IN, 96, DM, (bf16*)(ws + WS_WIN), 0, nb < 16 ? QK_SCALE : 1.f, scr, r, C.lane); continue; } r -= I_IN;
        if (r < I_OUT) { tr_item(P.w_m_out, DM, 32, DM, (bf16*)(ws + WS_WOUT), 0, 1.f, scr, r, C.lane); continue; } r -= I_OUT;
        if (r < 2 * I_UP) { const int l = r / I_UP, rr = r % I_UP, n0 = 32 * (rr % 176), half = n0 >= FF ? 1 : 0, cc = n0 - half * FF;
            tr_item(P.w_up + (size_t)l * DM * FF2, FF2, 176, DM, (bf16*)(ws + WS_WUP) + (size_t)l * FF2 * DM, (cc >> 7) * 256 + half * 128 + (cc & 127) - n0, 1.f, scr, rr, C.lane); continue; } r -= 2 * I_UP;
        if (r < 2 * I_DOWN) { const int l = r / I_DOWN; tr_item(P.w_down + (size_t)l * FF * DM, DM, 32, FF, (bf16*)(ws + WS_WDOWN) + (size_t)l * DM * FF, 0, 1.f, scr, r % I_DOWN, C.lane); continue; } r -= 2 * I_DOWN;
        if (r < I_DKV) { tr_item(P.w_dkv, 288, 9, DM, (bf16*)(ws + WS_WDKV), 0, 1.f, scr, r, C.lane); continue; } r -= I_DKV;
        if (r < I_DQ) { tr_item(P.w_dq, 384, 12, DM, (bf16*)(ws + WS_WDQ), 0, 1.f, scr, r, C.lane); continue; } r -= I_DQ;
        if (r < I_UQ) { tr_item(P.w_uq, QW, 48, 384, (bf16*)(ws + WS_WUQ), 0, ATT_C2, scr, r, C.lane); continue; } r -= I_UQ;
        if (r < I_UK) { tr_item(P.w_uk, DM, 32, 256, (bf16*)(ws + WS_WKV), 0, 1.f, scr, r, C.lane); continue; } r -= I_UK;
        if (r < I_UK) { tr_item(P.w_uv, DM, 32, 256, (bf16*)(ws + WS_WKV), 1024, 1.f, scr, r, C.lane); continue; } r -= I_UK;
        if (r < I_O) { tr_item(P.w_o, DM, 32, DM, (bf16*)(ws + WS_WO), 0, 1.f, scr, r, C.lane); continue; } r -= I_O;
        if (r < 2 * I_ADA) { const int l = r / I_ADA; tr_item(P.w_ada + (size_t)l * DM * 6144, 6144, 192, DM, (bf16*)(ws + WS_WMOD), l * 6144, 1.f, scr, r % I_ADA, C.lane); continue; } r -= 2 * I_ADA;
        tr_item(P.w_ada_kv, 2048, 64, DM, (bf16*)(ws + WS_WMOD), 12288, 1.f, scr, r, C.lane);
    }
    const int gt = C.vcu * NTHREADS + C.tid, NGT = C.G * NTHREADS;
    { v4u z = {0u, 0u, 0u, 0u};
      GAS v4u* a = (GAS v4u*)((bf16*)(ws + WS_WDKV) + (size_t)288 * DM); const int na = (512 - 288) * DM / 8;
      for (int i = gt; i < na; i += NGT) a[i] = z;
      GAS v4u* b = (GAS v4u*)((bf16*)(ws + WS_WDQ) + (size_t)384 * DM); const int nb = (512 - 384) * DM / 8;
      for (int i = gt; i < nb; i += NGT) b[i] = z; }
    { bf16* am = (bf16*)(ws + WS_AMOD);
      for (int i = gt; i < 256 * DM / 4; i += NGT) { const int row = i / (DM / 4), c4 = (i % (DM / 4)) * 4;
          f32x4 v = {0.f, 0.f, 0.f, 0.f};
          if (row < NS) v = *(const f32x4*)(P.c_s + (size_t)row * DM + c4); else if (row < NS + 2) v = *(const f32x4*)(P.c_p + (size_t)(row - NS) * DM + c4);
          u32x2 w; w.x = cvtpk(siluf_(v[0]), siluf_(v[1])); w.y = cvtpk(siluf_(v[2]), siluf_(v[3])); *(u32x2*)(am + (size_t)row * DM + c4) = w; } }
    { float* tab = (float*)(ws + WS_ROPE);
      for (int i = gt; i < 8193 * 16; i += NGT) { const int pos = i >> 4, k = i & 15;
          const double fr = exp2(-(double)k * (13.287712379549449 / 16.0)) * 0.15915494309189535;
          double t = (double)pos * fr; t -= floor(t); const float tf = (float)t;
          tab[i] = __builtin_amdgcn_cosf(tf); tab[8193 * 16 + i] = __builtin_amdgcn_sinf(tf); } }
}

__device__ __forceinline__ void load_row(const float* xr, int lane, f32x4 (&v)[4]) {
#pragma unroll
    for (int j = 0; j < 4; ++j) v[j] = *(const f32x4*)(xr + 4 * lane + 256 * j);
}
__device__ __forceinline__ float row_rstd(const f32x4 (&v)[4]) {
    float s = 0.f;
#pragma unroll
    for (int j = 0; j < 4; ++j) s += (v[j][0] * v[j][0] + v[j][1] * v[j][1]) + (v[j][2] * v[j][2] + v[j][3] * v[j][3]);
    return rsqrtf(wave_sum(s) * (1.f / DM) + EPSN);
}
__device__ __forceinline__ void mod_row(const f32x4 (&v)[4], float rstd, const float* g, const float* sc, const float* sh, int lane, f32x4 (&y)[4]) {
#pragma unroll
    for (int j = 0; j < 4; ++j) { const int c = 4 * lane + 256 * j; const f32x4 gv = *(const f32x4*)(g + c), scv = *(const f32x4*)(sc + c), shv = *(const f32x4*)(sh + c);
        y[j] = (v[j] * rstd) * gv * (scv + 1.0f) + shv; }
}
__device__ __forceinline__ void store_row_bf16(bf16* o, int lane, const f32x4 (&y)[4]) {
#pragma unroll
    for (int j = 0; j < 4; ++j) { u32x2 w; w.x = cvtpk(y[j][0], y[j][1]); w.y = cvtpk(y[j][2], y[j][3]); *(u32x2*)(o + 4 * lane + 256 * j) = w; }
}

__device__ __forceinline__ void p2_norm_in(const Params& P, const Ctx& C) {
    unsigned char* ws = P.ws; const float* MOD = (const float*)(ws + WS_MOD); float* X = (float*)(ws + WS_X); bf16* XN = (bf16*)(ws + WS_XN); float* GT = (float*)(ws + WS_GATES);
    f32x4 wg[4][4][2];
#pragma unroll
    for (int j = 0; j < 4; ++j)
#pragma unroll
        for (int e = 0; e < 4; ++e) { const int k = 4 * C.lane + 256 * j + e; wg[j][e][0] = *(const f32x4*)(P.w_m_in + (size_t)k * LDW_IN + NIN); wg[j][e][1] = *(const f32x4*)(P.w_m_in + (size_t)k * LDW_IN + NIN + 4); }
    for (int r = C.gw; r < MT; r += C.NGW) {
        f32x4 v[4];
        if (r < MP) load_row(P.x_p + (size_t)r * DM, C.lane, v); else if (r < MP + NS) load_row(P.x_s + (size_t)(r - MP) * DM, C.lane, v);
        else { for (int j = 0; j < 4; ++j) v[j] = (f32x4){0.f, 0.f, 0.f, 0.f}; }
#pragma unroll
        for (int j = 0; j < 4; ++j) *(f32x4*)(X + (size_t)r * DM + 4 * C.lane + 256 * j) = v[j];
        const float rstd = row_rstd(v); const float* mr = MOD + (size_t)mrow_of(r) * NMOD;
        f32x4 y[4]; mod_row(v, rstd, P.g_norm1, mr + 1024, mr, C.lane, y);
        store_row_bf16(XN + (size_t)r * DM, C.lane, y);
        f32x4 g0 = {0.f, 0.f, 0.f, 0.f}, g1 = {0.f, 0.f, 0.f, 0.f};
#pragma unroll
        for (int j = 0; j < 4; ++j)
#pragma unroll
            for (int e = 0; e < 4; ++e) { g0 += wg[j][e][0] * y[j][e]; g1 += wg[j][e][1] * y[j][e]; }
#pragma unroll
        for (int q = 0; q < 4; ++q) { g0[q] = wave_sum(g0[q]); g1[q] = wave_sum(g1[q]); }
        if (C.lane == 0) { const f32x4 b0 = *(const f32x4*)(P.b_m_gates), b1 = *(const f32x4*)(P.b_m_gates + 4);
            g0 += b0; g1 += b1; f32x4 lf; lf[0] = log_sigmoidf_(g1[0]); lf[1] = log_sigmoidf_(g1[1]); lf[2] = log_sigmoidf_(g1[2]); lf[3] = log_sigmoidf_(g1[3]);
            *(f32x4*)(GT + (size_t)r * 8) = g0; *(f32x4*)(GT + (size_t)r * 8 + 4) = lf; }
    }
}
__device__ __forceinline__ void norm_rows(const Params& P, const Ctx& C, const float* g, int sc_off, int sh_off, bf16* dst, const float* g2, int sc2_off, int sh2_off, bf16* dst2) {
    unsigned char* ws = P.ws; const float* MOD = (const float*)(ws + WS_MOD); const float* X = (const float*)(ws + WS_X);
    for (int r = C.gw; r < MT; r += C.NGW) {
        f32x4 v[4]; load_row(X + (size_t)r * DM, C.lane, v);
        const float rstd = row_rstd(v); const float* mr = MOD + (size_t)mrow_of(r) * NMOD;
        f32x4 y[4]; mod_row(v, rstd, g, mr + sc_off, mr + sh_off, C.lane, y); store_row_bf16(dst + (size_t)r * DM, C.lane, y);
        if (dst2) { mod_row(v, rstd, g2, mr + sc2_off, mr + sh2_off, C.lane, y); store_row_bf16(dst2 + (size_t)r * DM, C.lane, y); }
    }
}
__device__ __forceinline__ void final_norm(const Params& P, const Ctx& C) {
    const float* X = (const float*)(P.ws + WS_X);
    for (int r = C.gw; r < MP + NS; r += C.NGW) {
        f32x4 v[4]; load_row(X + (size_t)r * DM, C.lane, v); const float rstd = row_rstd(v);
        float* o = P.out + (r < MP ? O_YP + (size_t)r * DM : O_YS + (size_t)(r - MP) * DM);
#pragma unroll
        for (int j = 0; j < 4; ++j) { const int c = 4 * C.lane + 256 * j; *(f32x4*)(o + c) = (v[j] * rstd) * *(const f32x4*)(P.g_final + c); }
    }
}
__device__ __forceinline__ void latent_rows(const Params& P, const Ctx& C) {
    unsigned char* ws = P.ws; const float* LAT = (const float*)(ws + WS_LAT); const float* QLAT = (const float*)(ws + WS_QLAT); const float* tab = (const float*)(ws + WS_ROPE);
    bf16* CKV = (bf16*)(ws + WS_CKV); bf16* KPE = (bf16*)(ws + WS_KPE); bf16* QN = (bf16*)(ws + WS_QN);
    for (int r = C.gw; r < MT; r += C.NGW) {
        const float* lr = LAT + (size_t)r * 512; const int lane = C.lane;
        const f32x4 v = *(const f32x4*)(lr + 4 * lane);
        const float ss = wave_sum((v[0] * v[0] + v[1] * v[1]) + (v[2] * v[2] + v[3] * v[3])); const float rstd = rsqrtf(ss * (1.f / 256.f) + EPSN);
        const f32x4 o = (v * rstd) * *(const f32x4*)(P.g_kv + 4 * lane);
        { u32x2 w; w.x = cvtpk(o[0], o[1]); w.y = cvtpk(o[2], o[3]); *(u32x2*)(CKV + (size_t)r * 256 + 4 * lane) = w; }
        float* ock = nullptr; float* okp = nullptr;
        if (r < MP) { ock = P.out + O_CKVP + (size_t)r * 256; okp = P.out + O_KPEP + (size_t)r * 32; }
        else if (r < MP + NS) { ock = P.out + O_CKVS + (size_t)(r - MP) * 256; okp = P.out + O_KPES + (size_t)(r - MP) * 32; }
        if (ock) *(f32x4*)(ock + 4 * lane) = o;
        { const int pos = pos_of(r); const int i = lane & 15; const float x1 = lr[256 + i], x2 = lr[272 + i]; const float c = tab[pos * 16 + i], s = tab[8193 * 16 + pos * 16 + i];
          const float o1 = x1 * c - x2 * s, o2 = x1 * s + x2 * c;
          if (lane < 16) { KPE[(size_t)r * 32 + i] = (bf16)(cvtpk(o1, 0.f) & 0xffffu); KPE[(size_t)r * 32 + 16 + i] = (bf16)(cvtpk(o2, 0.f) & 0xffffu); if (okp) { okp[i] = o1; okp[16 + i] = o2; } } }
        { const float* qr = QLAT + (size_t)r * 512; f32x2 q[3]; float s = 0.f;
#pragma unroll
          for (int j = 0; j < 3; ++j) { q[j] = *(const f32x2*)(qr + 2 * lane + 128 * j); s += q[j][0] * q[j][0] + q[j][1] * q[j][1]; }
          const float rq = rsqrtf(wave_sum(s) * (1.f / 384.f) + EPSN);
#pragma unroll
          for (int j = 0; j < 3; ++j) { const f32x2 g = *(const f32x2*)(P.g_q + 2 * lane + 128 * j); *(unsigned*)(QN + (size_t)r * 384 + 2 * lane + 128 * j) = cvtpk(q[j][0] * rq * g[0], q[j][1] * rq * g[1]); } }
    }
}
__device__ __forceinline__ void conv_phase(const Params& P, const Ctx& C, int layer) {
    unsigned char* ws = P.ws; const bf16* AG = (const bf16*)(ws + WS_AG); bf16* U = (bf16*)(ws + WS_U);
    const float* wc = P.w_conv + (size_t)layer * 3 * FF; const float* bc = P.b_conv + (size_t)layer * FF;
    const int gt = C.vcu * NTHREADS + C.tid, NGT = C.G * NTHREADS;
    constexpr int NCH = FF / 8, RB = 32, NRB = MP / RB;
    for (int it = gt; it < NRB * NCH; it += NGT) {
        const int rb = it / NCH, ch = it % NCH, c0 = ch * 8, r0 = rb * RB;
        float w0[8], w1[8], w2[8], bb[8];
#pragma unroll
        for (int q = 0; q < 2; ++q) { const f32x4 a = *(const f32x4*)(wc + c0 + 4 * q), b = *(const f32x4*)(wc + FF + c0 + 4 * q), c = *(const f32x4*)(wc + 2 * FF + c0 + 4 * q), d = *(const f32x4*)(bc + c0 + 4 * q);
#pragma unroll
            for (int e = 0; e < 4; ++e) { w0[4 * q + e] = a[e]; w1[4 * q + e] = b[e]; w2[4 * q + e] = c[e]; bb[4 * q + e] = d[e]; } }
        float p2[8], p1[8];
        const bool first = (r0 & (SEQ - 1)) == 0;
        { v4u t2 = {0u, 0u, 0u, 0u}, t1 = {0u, 0u, 0u, 0u};
          if (!first) { t2 = *(const v4u*)(AG + (size_t)(r0 - 2) * FF2 + c0); t1 = *(const v4u*)(AG + (size_t)(r0 - 1) * FF2 + c0); }
#pragma unroll
          for (int e = 0; e < 4; ++e) { p2[2 * e] = bf_lo(t2[e]); p2[2 * e + 1] = bf_hi(t2[e]); p1[2 * e] = bf_lo(t1[e]); p1[2 * e + 1] = bf_hi(t1[e]); } }
#pragma unroll 4
        for (int rr = 0; rr < RB; ++rr) { const int r = r0 + rr;
            const v4u ta = *(const v4u*)(AG + (size_t)r * FF2 + c0), tg = *(const v4u*)(AG + (size_t)r * FF2 + FF + c0);
            float a[8], o[8];
#pragma unroll
            for (int e = 0; e < 4; ++e) { a[2 * e] = bf_lo(ta[e]); a[2 * e + 1] = bf_hi(ta[e]); }
#pragma unroll
            for (int e = 0; e < 8; ++e) { const float cv = bb[e] + w0[e] * p2[e] + w1[e] * p1[e] + w2[e] * a[e]; const float gv = (e & 1) ? bf_hi(tg[e >> 1]) : bf_lo(tg[e >> 1]); o[e] = siluf_(cv) * gv; p2[e] = p1[e]; p1[e] = a[e]; }
            v4u w; w.x = cvtpk(o[0], o[1]); w.y = cvtpk(o[2], o[3]); w.z = cvtpk(o[4], o[5]); w.w = cvtpk(o[6], o[7]);
            *(v4u*)(U + (size_t)r * FF + c0) = w;
            if ((r & (SEQ - 1)) >= SEQ - 2) { float* oc = P.out + O_CONVP + ((size_t)(layer * 2 + (r >> 13)) * 2 + ((r & (SEQ - 1)) - (SEQ - 2))) * FF + c0;
                *(f32x4*)oc = (f32x4){a[0], a[1], a[2], a[3]}; *(f32x4*)(oc + 4) = (f32x4){a[4], a[5], a[6], a[7]}; }
        }
    }
    for (int it = gt; it < 256 * NCH; it += NGT) {
        const int s = it / NCH, ch = it % NCH, c0 = ch * 8, r = MP + s;
        v4u w = {0u, 0u, 0u, 0u};
        if (s < NS) {
            const float* sc = P.st_conv + ((size_t)(layer * NS + s) * 2) * FF + c0;
            const v4u ta = *(const v4u*)(AG + (size_t)r * FF2 + c0), tg = *(const v4u*)(AG + (size_t)r * FF2 + FF + c0);
            float o[8], a[8];
#pragma unroll
            for (int e = 0; e < 4; ++e) { a[2 * e] = bf_lo(ta[e]); a[2 * e + 1] = bf_hi(ta[e]); }
#pragma unroll
            for (int e = 0; e < 8; ++e) { const float cv = bc[c0 + e] + wc[c0 + e] * sc[e] + wc[FF + c0 + e] * sc[FF + e] + wc[2 * FF + c0 + e] * a[e];
                const float gv = (e & 1) ? bf_hi(tg[e >> 1]) : bf_lo(tg[e >> 1]); o[e] = siluf_(cv) * gv; }
            w.x = cvtpk(o[0], o[1]); w.y = cvtpk(o[2], o[3]); w.z = cvtpk(o[4], o[5]); w.w = cvtpk(o[6], o[7]);
            float* oc = P.out + O_CONVS + ((size_t)(layer * NS + s) * 2) * FF + c0;
#pragma unroll
            for (int e = 0; e < 8; ++e) { oc[e] = sc[FF + e]; oc[FF + e] = a[e]; }
        }
        *(v4u*)(U + (size_t)r * FF + c0) = w;
    }
}
typedef short v4i16_t __attribute__((ext_vector_type(4)));
#define MFMA16(a, b, c) __builtin_amdgcn_mfma_f32_16x16x32_bf16((a), (b), (c), 0, 0, 0)
__device__ __forceinline__ s16x4 vtr(LAS const unsigned char* p) { return __builtin_bit_cast(s16x4, __builtin_amdgcn_ds_read_tr16_b64_v4i16((LAS v4i16_t*)p)); }
__device__ __forceinline__ bf16x8 tr_frag(LAS const unsigned char* tile, int stride, int krow0, int c0, int lane) {
    const int g = lane >> 4, q = (lane >> 2) & 3, p = lane & 3;
    LAS const unsigned char* a = tile + (krow0 + 8 * g + q) * stride + (c0 + 4 * p) * 2;
    const s16x4 lo = vtr(a), hi = vtr(a + 4 * stride);
    return (bf16x8){lo[0], lo[1], lo[2], lo[3], hi[0], hi[1], hi[2], hi[3]};
}
constexpr int KS_STRIDE = 272, VS_STRIDE = 528, PS_STRIDE = 144;

__device__ __forceinline__ void m1_unit(const Params& P, const Ctx& C, int bh, int c) {
    unsigned char* ws = P.ws; const bf16* QKVO = (const bf16*)(ws + WS_QKVO); const float* GT = (const float*)(ws + WS_GATES);
    bf16* CT = (bf16*)(ws + WS_CT); float* NL = (float*)(ws + WS_NL); float* CHK = (float*)(ws + WS_CHK);
    const int b = bh >> 2, h = bh & 3, r0 = b * SEQ + c * 64, lane = C.lane, tid = C.tid, wave = C.wave;
    LAS unsigned char* Ks = C.lds; LAS unsigned char* Vs = C.lds + 64 * KS_STRIDE;
    const float lf = GT[(size_t)(r0 + lane) * 8 + 4 + h], li = GT[(size_t)(r0 + lane) * 8 + h];
    const float bcum = wave_scan_add(lf, lane); const float g = __shfl(bcum, 63);
    const float a = g - bcum + li; const float mloc = wave_max(a); const float wa = __expf(a - mloc);
    if (tid == 0) { CHK[bh * 128 + c] = g; CHK[1024 + bh * 128 + c] = mloc; }
#pragma unroll
    for (int i = 0; i < 2; ++i) { const int j = (tid >> 4) + 32 * i, ch = tid & 15;
        const v4u kv = *(const v4u*)(QKVO + (size_t)(r0 + j) * NIN + 512 + h * 128 + ch * 8); const float w = __shfl(wa, j);
        v4u o;
#pragma unroll
        for (int e = 0; e < 4; ++e) o[e] = cvtpk(bf_lo(kv[e]) * w, bf_hi(kv[e]) * w);
        *(LAS v4u*)(Ks + j * KS_STRIDE + ch * 16) = o; }
#pragma unroll
    for (int i = 0; i < 4; ++i) { const int j = (tid >> 5) + 16 * i, ch = tid & 31;
        *(LAS v4u*)(Vs + j * VS_STRIDE + ch * 16) = *(const v4u*)(QKVO + (size_t)(r0 + j) * NIN + 1024 + h * 256 + ch * 8); }
    __syncthreads();
    if (tid < 128) { float s = 0.f;
#pragma unroll 8
        for (int j = 0; j < 64; ++j) s += bf2f(*(LAS const bf16*)(Ks + j * KS_STRIDE + tid * 2));
        NL[(size_t)(bh * 128 + c) * 128 + tid] = s; }
    f32x4 acc[8][2];
#pragma unroll
    for (int dt = 0; dt < 8; ++dt) { acc[dt][0] = (f32x4){0.f, 0.f, 0.f, 0.f}; acc[dt][1] = (f32x4){0.f, 0.f, 0.f, 0.f}; }
#pragma unroll
    for (int ks = 0; ks < 2; ++ks) {
        const bf16x8 bv0 = tr_frag(Vs, VS_STRIDE, 32 * ks, 32 * wave, lane), bv1 = tr_frag(Vs, VS_STRIDE, 32 * ks, 32 * wave + 16, lane);
#pragma unroll
        for (int dt = 0; dt < 8; ++dt) { const bf16x8 ak = tr_frag(Ks, KS_STRIDE, 32 * ks, 16 * dt, lane);
            acc[dt][0] = MFMA16(ak, bv0, acc[dt][0]); acc[dt][1] = MFMA16(ak, bv1, acc[dt][1]); }
    }
#pragma unroll
    for (int dt = 0; dt < 8; ++dt)
#pragma unroll
        for (int et = 0; et < 2; ++et) { const int e = 32 * wave + 16 * et + (lane & 15), d0 = 16 * dt + 4 * (lane >> 4);
            u32x2 w; w.x = cvtpk(acc[dt][et][0], acc[dt][et][1]); w.y = cvtpk(acc[dt][et][2], acc[dt][et][3]);
            *(u32x2*)(CT + ((size_t)(bh * 128 + c) * 256 + e) * 128 + d0) = w; }
    __syncthreads();
}

__device__ __forceinline__ void mstep_unit(const Params& P, const Ctx& C, int s, int h) {
    unsigned char* ws = P.ws; const bf16* QKVO = (const bf16*)(ws + WS_QKVO); const float* GT = (const float*)(ws + WS_GATES); bf16* HH = (bf16*)(ws + WS_XN);
    const int r = MP + s, tid = C.tid, lane = C.lane, wave = C.wave;
    LAS float* qs = (LAS float*)C.lds; LAS float* red = qs + 512; LAS float* misc = qs + 512 + 2048;
    { const bf16* src = QKVO + (size_t)r * NIN; float val;
      if (tid < 128) val = bf2f(src[h * 128 + tid]); else if (tid < 256) val = bf2f(src[512 + h * 128 + (tid - 128)]); else val = bf2f(src[1024 + h * 256 + (tid - 256)]);
      qs[tid] = val; }
    const float li = GT[(size_t)r * 8 + h], lf = GT[(size_t)r * 8 + 4 + h], m_st = P.st_m[s * 4 + h];
    const float m_new = fmaxf(lf + m_st, li), fw = __expf(lf + m_st - m_new), iw = __expf(li - m_new);
    __syncthreads();
    const int e4 = (tid & 63) * 4;
    f32x4 num = {0.f, 0.f, 0.f, 0.f}; const f32x4 vv = *(LAS const f32x4*)(qs + 256 + e4);
    const size_t cbase = (size_t)(s * 4 + h) * 128 * 256;
#pragma unroll
    for (int dd = 0; dd < 16; ++dd) { const int d = 16 * wave + dd; const f32x4 c4 = *(const f32x4*)(P.st_C + cbase + (size_t)d * 256 + e4); const float kd = qs[128 + d], qd = qs[d];
        const f32x4 cn = c4 * fw + vv * (iw * kd); *(f32x4*)(P.out + O_CS + cbase + (size_t)d * 256 + e4) = cn; num += cn * qd; }
    *(LAS f32x4*)(red + wave * 256 + e4) = num;
    float dpart = 0.f;
    if (tid < 128) { const float nn = fw * P.st_n[(size_t)(s * 4 + h) * 128 + tid] + iw * qs[128 + tid]; P.out[O_NS + (size_t)(s * 4 + h) * 128 + tid] = nn; dpart = qs[tid] * nn; }
    dpart = wave_sum(dpart); if (lane == 0) misc[wave] = dpart;
    __syncthreads();
    const float den = misc[0] + misc[1]; const float inv = 1.0f / fmaxf(fabsf(den), __expf(-m_new));
    float hv = 0.f;
    if (tid < 256) { float sum = 0.f;
#pragma unroll
        for (int w = 0; w < 8; ++w) sum += red[w * 256 + tid];
        hv = sum * inv; }
    const float ss = wave_sum(hv * hv); if (lane == 0) misc[8 + wave] = ss;
    __syncthreads();
    float tot = 0.f;
#pragma unroll
    for (int w = 0; w < 8; ++w) tot += misc[8 + w];
    const float rstd = rsqrtf(tot * (1.f / 256.f) + EPSN);
    if (tid < 256) { const float og = bf2f(QKVO[(size_t)r * NIN + 2048 + h * 256 + tid]); const float o = hv * rstd * P.g_m_head[h * 256 + tid] * sigmoidf_(og);
        HH[(size_t)r * DM + h * 256 + tid] = (bf16)(cvtpk(o, 0.f) & 0xffffu); }
    if (tid == 0) P.out[O_MS + s * 4 + h] = m_new;
    __syncthreads();
}

__device__ __forceinline__ void m2_scan(const Params& P, const Ctx& C) {
    unsigned char* ws = P.ws; unsigned* CT32 = (unsigned*)(ws + WS_CT); float* NL = (float*)(ws + WS_NL); float* CHK = (float*)(ws + WS_CHK);
    const int gt = C.vcu * NTHREADS + C.tid, NGT = C.G * NTHREADS;
    for (int idx = gt; idx < 8 * 16384; idx += NGT) {
        const int bh = idx >> 14, p = idx & 16383, e = p >> 6, d = (p & 63) * 2;
        unsigned* ct = CT32 + (((size_t)bh * 128 * 256 + e) * 128 + d) / 2;
        const bool do_n = p < 128; float* nl = NL + (size_t)bh * 128 * 128 + (do_n ? p : 0);
        float c0 = 0.f, c1 = 0.f, m = 0.f, nst = 0.f;
        for (int cb = 0; cb < 128; cb += 8) {
            unsigned cur[8]; float nv[8];
#pragma unroll
            for (int k = 0; k < 8; ++k) { cur[k] = ct[(size_t)(cb + k) * 16384]; nv[k] = do_n ? nl[(cb + k) * 128] : 0.f; }
#pragma unroll
            for (int k = 0; k < 8; ++k) { const int c = cb + k; const float g = CHK[bh * 128 + c], ml = CHK[1024 + bh * 128 + c];
                const float m_new = fmaxf(g + m, ml), fw = __expf(g + m - m_new), lw = __expf(ml - m_new);
                ct[(size_t)c * 16384] = cvtpk(c0, c1); c0 = fw * c0 + lw * bf_lo(cur[k]); c1 = fw * c1 + lw * bf_hi(cur[k]);
                if (do_n) { nl[c * 128] = nst; nst = fw * nst + lw * nv[k]; }
                if (p == 0) CHK[2048 + bh * 128 + c] = m;
                m = m_new; }
        }
        P.out[O_CP + ((size_t)bh * 128 + d) * 256 + e] = c0; P.out[O_CP + ((size_t)bh * 128 + d + 1) * 256 + e] = c1;
        if (do_n) P.out[O_NP + bh * 128 + p] = nst;
        if (p == 0) P.out[O_MP + bh] = m;
    }
}

__device__ __forceinline__ void m3_unit(const Params& P, const Ctx& C, int bh, int c) {
    unsigned char* ws = P.ws; const bf16* QKVO = (const bf16*)(ws + WS_QKVO); const float* GT = (const float*)(ws + WS_GATES);
    const bf16* CT = (const bf16*)(ws + WS_CT); const float* NL = (const float*)(ws + WS_NL); const float* CHK = (const float*)(ws + WS_CHK); bf16* HH = (bf16*)(ws + WS_XN);
    const int b = bh >> 2, h = bh & 3, r0 = b * SEQ + c * 64, lane = C.lane, tid = C.tid, wave = C.wave, g = lane >> 4, l15 = lane & 15;
    LAS unsigned char* Qs = C.lds; LAS unsigned char* Ks = C.lds + 17408; LAS unsigned char* Vs = C.lds + 34816; LAS unsigned char* Ps = C.lds + 68608;
    LAS float* sb = (LAS float*)(C.lds + 77824); LAS float* su = sb + 64; LAS float* sms = sb + 128; LAS float* swi = sb + 192; LAS float* sqn = sb + 256; LAS float* dsum = sb + 320; LAS float* ssq = sb + 576;
    { const float lf = GT[(size_t)(r0 + lane) * 8 + 4 + h], li = GT[(size_t)(r0 + lane) * 8 + h];
      const float bcum = wave_scan_add(lf, lane); const float u = li - bcum; const float pm = wave_scan_max(u, lane); const float mprev = CHK[2048 + bh * 128 + c];
      const float w0 = bcum + mprev, ms = fmaxf(w0, bcum + pm), wi = __expf(w0 - ms);
      if (wave == 0) { sb[lane] = bcum - ms; su[lane] = u; sms[lane] = ms; swi[lane] = wi; } }
    bf16x8 bC[2][4];
#pragma unroll
    for (int et = 0; et < 2; ++et)
#pragma unroll
        for (int ks = 0; ks < 4; ++ks) bC[et][ks] = *(const bf16x8*)(CT + ((size_t)(bh * 128 + c) * 256 + 32 * wave + 16 * et + l15) * 128 + 32 * ks + 8 * g);
#pragma unroll
    for (int i = 0; i < 2; ++i) { const int j = (tid >> 4) + 32 * i, ch = tid & 15; const bf16* src = QKVO + (size_t)(r0 + j) * NIN + h * 128 + ch * 8;
        *(LAS v4u*)(Qs + j * KS_STRIDE + ch * 16) = *(const v4u*)src; *(LAS v4u*)(Ks + j * KS_STRIDE + ch * 16) = *(const v4u*)(src + 512); }
#pragma unroll
    for (int i = 0; i < 4; ++i) { const int j = (tid >> 5) + 16 * i, ch = tid & 31;
        *(LAS v4u*)(Vs + j * VS_STRIDE + ch * 16) = *(const v4u*)(QKVO + (size_t)(r0 + j) * NIN + 1024 + h * 256 + ch * 8); }
    __syncthreads();
    { const int i = 8 * wave + (lane >> 3), d0 = (lane & 7) * 16; float s = 0.f; const float* np = NL + (size_t)(bh * 128 + c) * 128 + d0;
#pragma unroll
      for (int dd = 0; dd < 16; ++dd) s += bf2f(*(LAS const bf16*)(Qs + i * KS_STRIDE + (d0 + dd) * 2)) * np[dd];
      s += __shfl_xor(s, 1); s += __shfl_xor(s, 2); s += __shfl_xor(s, 4); if ((lane & 7) == 0) sqn[i] = s; }
    { const int jt = wave >> 1;
#pragma unroll
      for (int tt = 0; tt < 2; ++tt) { const int it = 2 * (wave & 1) + tt, i = 16 * it + l15;
          u32x2 pw = {0u, 0u}; float psum = 0.f;
          if (jt <= it) { f32x4 sacc = {0.f, 0.f, 0.f, 0.f};
#pragma unroll
              for (int ks = 0; ks < 4; ++ks) { const bf16x8 a = *(LAS const bf16x8*)(Ks + (16 * jt + l15) * KS_STRIDE + (32 * ks + 8 * g) * 2), bq = *(LAS const bf16x8*)(Qs + (16 * it + l15) * KS_STRIDE + (32 * ks + 8 * g) * 2);
                  sacc = MFMA16(a, bq, sacc); }
              const float bim = sb[i]; float pv[4];
#pragma unroll
              for (int ii = 0; ii < 4; ++ii) { const int j = 16 * jt + 4 * g + ii; pv[ii] = (j <= i) ? sacc[ii] * __expf(bim + su[j]) : 0.f; psum += pv[ii]; }
              pw.x = cvtpk(pv[0], pv[1]); pw.y = cvtpk(pv[2], pv[3]); }
          *(LAS u32x2*)(Ps + i * PS_STRIDE + (16 * jt + 4 * g) * 2) = pw;
          psum += __shfl_xor(psum, 16); psum += __shfl_xor(psum, 32); if (g == 0) dsum[jt * 64 + i] = psum; } }
    __syncthreads();
    f32x4 ai[4][2], ax[4][2];
#pragma unroll
    for (int it = 0; it < 4; ++it)
#pragma unroll
        for (int et = 0; et < 2; ++et) { ai[it][et] = (f32x4){0.f, 0.f, 0.f, 0.f}; ax[it][et] = (f32x4){0.f, 0.f, 0.f, 0.f}; }
#pragma unroll
    for (int ks = 0; ks < 4; ++ks)
#pragma unroll
        for (int it = 0; it < 4; ++it) { const bf16x8 aq = *(LAS const bf16x8*)(Qs + (16 * it + l15) * KS_STRIDE + (32 * ks + 8 * g) * 2);
            ai[it][0] = MFMA16(aq, bC[0][ks], ai[it][0]); ai[it][1] = MFMA16(aq, bC[1][ks], ai[it][1]); }
#pragma unroll
    for (int ks = 0; ks < 2; ++ks) { const bf16x8 bv0 = tr_frag(Vs, VS_STRIDE, 32 * ks, 32 * wave, lane), bv1 = tr_frag(Vs, VS_STRIDE, 32 * ks, 32 * wave + 16, lane);
#pragma unroll
        for (int it = 0; it < 4; ++it) { const bf16x8 ap = *(LAS const bf16x8*)(Ps + (16 * it + l15) * PS_STRIDE + (32 * ks + 8 * g) * 2);
            ax[it][0] = MFMA16(ap, bv0, ax[it][0]); ax[it][1] = MFMA16(ap, bv1, ax[it][1]); } }
#pragma unroll
    for (int it = 0; it < 4; ++it)
#pragma unroll
        for (int ii = 0; ii < 4; ++ii) { const int i = 16 * it + 4 * g + ii; const float wi = swi[i];
            const float den = wi * sqn[i] + (dsum[i] + dsum[64 + i]) + (dsum[128 + i] + dsum[192 + i]); const float inv = 1.0f / fmaxf(fabsf(den), __expf(-sms[i]));
            const float h0 = (wi * ai[it][0][ii] + ax[it][0][ii]) * inv, h1 = (wi * ai[it][1][ii] + ax[it][1][ii]) * inv; ai[it][0][ii] = h0; ai[it][1][ii] = h1;
            float ss = h0 * h0 + h1 * h1; ss += __shfl_xor(ss, 1); ss += __shfl_xor(ss, 2); ss += __shfl_xor(ss, 4); ss += __shfl_xor(ss, 8);
            if (l15 == 0) ssq[wave * 64 + i] = ss; }
    __syncthreads();
#pragma unroll
    for (int it = 0; it < 4; ++it)
#pragma unroll
        for (int ii = 0; ii < 4; ++ii) { const int i = 16 * it + 4 * g + ii; float tot = 0.f;
#pragma unroll
            for (int w = 0; w < 8; ++w) tot += ssq[w * 64 + i];
            const float rstd = rsqrtf(tot * (1.f / 256.f) + EPSN);
#pragma unroll
            for (int et = 0; et < 2; ++et) { const int e = 32 * wave + 16 * et + l15; const float og = bf2f(QKVO[(size_t)(r0 + i) * NIN + 2048 + h * 256 + e]);
                const float o = ai[it][et][ii] * rstd * P.g_m_head[h * 256 + e] * sigmoidf_(og); HH[(size_t)(r0 + i) * DM + h * 256 + e] = (bf16)(cvtpk(o, 0.f) & 0xffffu); } }
    __syncthreads();
}
namespace att {
constexpr int QB = 256, KVBLK = 64, NSLOT = 3, KSLOT = 12288, VSLOT = 8192;
constexpr int LDS_K = 0, LDS_V = NSLOT * KSLOT, LDS_WS = LDS_V + NSLOT * VSLOT, LDS_OST = LDS_WS + 8 * 256, LDS_BYTES = LDS_OST + 8 * 4096;
#define MFMA32(a, b, c) __builtin_amdgcn_mfma_f32_32x32x16_bf16((a), (b), (c), 0, 0, 0)
__device__ __forceinline__ int crow(int r, int hi) { return (r & 3) + 8 * (r >> 2) + 4 * hi; }
__device__ __forceinline__ void glds16(const void* gsrc, unsigned lds_dst) { unsigned keep;
    asm volatile("s_mov_b32 %0, m0\n\ts_mov_b32 m0, %2\n\ts_nop 0\n\tglobal_load_lds_dwordx4 %1, off\n\ts_mov_b32 m0, %0" : "=&s"(keep) : "v"(gsrc), "s"(lds_dst) : "memory"); }
#define MX3(a, b, c) __builtin_fmaxf(__builtin_fmaxf((a), (b)), (c))
__device__ __forceinline__ float rowmax(const f32x16& p0, const f32x16& p1) {
    float a = MX3(p0[0], p0[1], p1[0]), b = MX3(p0[2], p0[3], p1[1]); a = MX3(a, p1[2], p1[3]);
#pragma unroll
    for (int r = 4; r < 16; r += 4) { a = MX3(a, p0[r], p0[r + 1]); b = MX3(b, p0[r + 2], p0[r + 3]); a = MX3(a, p1[r], p1[r + 1]); b = MX3(b, p1[r + 2], p1[r + 3]); }
    float m = __builtin_fmaxf(a, b); auto rr = __builtin_amdgcn_permlane32_swap(__float_as_uint(m), __float_as_uint(m), false, false);
    return __builtin_fmaxf(__uint_as_float(rr[0]), __uint_as_float(rr[1])); }
__device__ __forceinline__ void cmask(f32x16& p0, f32x16& p1, int jb, int qrel, int hi) {
    const int kb = 64 * jb + 4 * hi;
#pragma unroll
    for (int r = 0; r < 16; ++r) { const int kv = kb + (r & 3) + 8 * (r >> 2); if (kv > qrel) p0[r] = -INFINITY; if (kv + 32 > qrel) p1[r] = -INFINITY; } }

__device__ __forceinline__ void attn_unit(int b, int h, int qb, const bf16* Q, const bf16* __restrict__ KN, const bf16* __restrict__ KPE, const bf16* __restrict__ V, bf16* O, const float* __restrict__ tab, LAS unsigned char* shm) {
    const int tid = threadIdx.x, lane = tid & 63, r32 = lane & 31, hi = lane >> 5; const int wid = __builtin_amdgcn_readfirstlane(tid >> 6);
    const long rowbase = (long)b * SEQ; const int q0 = qb * QB, NT = (q0 + QB) / KVBLK;
    const bf16* Qw = Q + (rowbase + q0 + wid * 32) * QW + h * 96;
    const unsigned lds0 = (unsigned)(uintptr_t)shm; LAS float* wsf = (LAS float*)(shm + LDS_WS) + wid * 64;
    const bf16* ksrc = KN + (rowbase + lane) * DM + h * 64 + wid * 8;
    const bf16* psrc = KPE + (rowbase + lane) * 32 + (wid & 3) * 8;
    const bf16* vsrc = V + (rowbase + 16 * (wid & 3) + (lane >> 2)) * DM + h * 64 + (wid >> 2) * 32 + (lane & 3) * 8;
    const unsigned kdst = lds0 + LDS_K + wid * 1024, pdst = lds0 + LDS_K + (8 + (wid & 3)) * 1024, vdst = lds0 + LDS_V + wid * 1024;
#define DMA_T(t, sl) do { glds16(ksrc + (long)(t) * KVBLK * DM, (unsigned)__builtin_amdgcn_readfirstlane(kdst + (sl) * KSLOT)); \
                          glds16(psrc + (long)(t) * KVBLK * 32, (unsigned)__builtin_amdgcn_readfirstlane(pdst + (sl) * KSLOT)); \
                          glds16(vsrc + (long)(t) * KVBLK * DM, (unsigned)__builtin_amdgcn_readfirstlane(vdst + (sl) * VSLOT)); } while (0)
    bf16x8 qr[6];
#pragma unroll
    for (int d0 = 0; d0 < 6; ++d0) qr[d0] = *reinterpret_cast<const bf16x8*>(&Qw[(long)r32 * QW + d0 * 16 + hi * 8]);
    {
      const int pos = q0 + wid * 32 + r32; const float* cp = tab + pos * 16 + 8 * hi; const float* sp = cp + 8193 * 16;
      const f32x4 c0 = *(const f32x4*)cp, c1 = *(const f32x4*)(cp + 4), s0 = *(const f32x4*)sp, s1 = *(const f32x4*)(sp + 4);
      const v4u a = __builtin_bit_cast(v4u, qr[4]), bq = __builtin_bit_cast(v4u, qr[5]); v4u oa, ob;
#pragma unroll
      for (int e = 0; e < 4; ++e) { const float cl = e < 2 ? c0[2 * e] : c1[2 * e - 4], ch = e < 2 ? c0[2 * e + 1] : c1[2 * e - 3], sl_ = e < 2 ? s0[2 * e] : s1[2 * e - 4], sh = e < 2 ? s0[2 * e + 1] : s1[2 * e - 3];
          const float x1l = bf_lo(a[e]), x1h = bf_hi(a[e]), x2l = bf_lo(bq[e]), x2h = bf_hi(bq[e]);
          oa[e] = cvtpk(x1l * cl - x2l * sl_, x1h * ch - x2h * sh); ob[e] = cvtpk(x1l * sl_ + x2l * cl, x1h * sh + x2h * ch); }
      qr[4] = __builtin_bit_cast(bf16x8, oa); qr[5] = __builtin_bit_cast(bf16x8, ob); }
    DMA_T(0, 0); DMA_T(1, 1);
    float m_run = -1e30f, l_reg = 0.f; f32x16 o[2]; o[0] = f32x16{}; o[1] = f32x16{};
    const int qrel = wid * 32 + r32;
    const LAS unsigned char* shm3 = shm;
    int sl = 0;
    for (int t = 0; t < NT; ++t) {
        if (t + 1 < NT) asm volatile("s_waitcnt vmcnt(3) lgkmcnt(0)\n\ts_barrier" ::: "memory"); else asm volatile("s_waitcnt vmcnt(0) lgkmcnt(0)\n\ts_barrier" ::: "memory");
        if (t + 2 < NT) { const int s2 = (sl == 0) ? 2 : sl - 1; DMA_T(t + 2, s2); }
        f32x16 p0 = f32x16{}, p1 = f32x16{};
        { const LAS unsigned char* kb = shm3 + LDS_K + sl * KSLOT + hi * 1024 + r32 * 16;
#pragma unroll
          for (int d0 = 0; d0 < 6; ++d0) { const bf16x8 b0 = *(const LAS bf16x8*)(kb + d0 * 2048), b1 = *(const LAS bf16x8*)(kb + d0 * 2048 + 512);
              p0 = MFMA32(b0, qr[d0], p0); p1 = MFMA32(b1, qr[d0], p1); } }
        if (t >= NT - 4) cmask(p0, p1, t - (NT - 4), qrel, hi);
        const float rm = rowmax(p0, p1); const float m_new = fmaxf(m_run, rm); const float alpha = __builtin_amdgcn_exp2f(m_run - m_new); m_run = m_new;
        float sacc = 0.f;
#pragma unroll
        for (int r = 0; r < 16; ++r) { p0[r] = __builtin_amdgcn_exp2f(p0[r] - m_new); p1[r] = __builtin_amdgcn_exp2f(p1[r] - m_new); sacc += p0[r] + p1[r]; }
        l_reg = l_reg * alpha + sacc;
        if (__any(alpha != 1.0f)) { if (hi == 0) wsf[r32] = alpha; asm volatile("s_waitcnt lgkmcnt(0)" ::: "memory");
#pragma unroll
            for (int d_ = 0; d_ < 2; ++d_)
#pragma unroll
                for (int r = 0; r < 16; ++r) o[d_][r] *= wsf[crow(r, hi)];
            asm volatile("s_waitcnt lgkmcnt(0)" ::: "memory"); }
        bf16x8 pa[4];
#pragma unroll
        for (int k = 0; k < 2; ++k) { v4u w0, w1;
#pragma unroll
            for (int e = 0; e < 4; ++e) { w0[e] = cvtpk(p0[8 * k + 2 * e], p0[8 * k + 2 * e + 1]); w1[e] = cvtpk(p1[8 * k + 2 * e], p1[8 * k + 2 * e + 1]); }
            pa[k] = __builtin_bit_cast(bf16x8, w0); pa[2 + k] = __builtin_bit_cast(bf16x8, w1); }
        { const LAS unsigned char* vb = shm3 + LDS_V + sl * VSLOT + ((lane >> 4) & 1) * 32 + (lane & 3) * 8 + (4 * hi + ((lane & 15) >> 2)) * 64;
#pragma unroll
          for (int d0 = 0; d0 < 2; ++d0)
#pragma unroll
              for (int ks = 0; ks < 4; ++ks) { const s16x4 lo = vtr(vb + d0 * 4096 + ks * 1024), hh = vtr(vb + d0 * 4096 + ks * 1024 + 512);
                  const bf16x8 vf = (bf16x8){lo[0], lo[1], lo[2], lo[3], hh[0], hh[1], hh[2], hh[3]};
                  o[d0] = MFMA32(pa[ks], vf, o[d0]); } }
        sl = (sl == 2) ? 0 : sl + 1;
    }
    { auto rr = __builtin_amdgcn_permlane32_swap(__float_as_uint(l_reg), __float_as_uint(l_reg), false, false); l_reg = __uint_as_float(rr[0]) + __uint_as_float(rr[1]); }
    if (hi == 0) wsf[32 + r32] = l_reg; asm volatile("s_waitcnt lgkmcnt(0)" ::: "memory");
    float rli[16];
#pragma unroll
    for (int r = 0; r < 16; ++r) rli[r] = __builtin_amdgcn_rcpf(wsf[32 + crow(r, hi)]);
    bf16* Ow = O + (rowbase + q0 + wid * 32) * DM + h * 64;
    { LAS bf16* stg = (LAS bf16*)(shm + LDS_OST) + wid * 2048;
#pragma unroll
      for (int r = 0; r < 16; ++r) { const int orow = crow(r, hi);
#pragma unroll
          for (int d0 = 0; d0 < 2; ++d0) stg[orow * 64 + d0 * 32 + r32] = (bf16)(cvtpk(o[d0][r] * rli[r], 0.f) & 0xffffu); }
      asm volatile("s_waitcnt lgkmcnt(0)" ::: "memory");
#pragma unroll
      for (int i = 0; i < 4; ++i) { const int row = i * 8 + (lane >> 3), ch = lane & 7; const v4u v = *(const LAS v4u*)(stg + row * 64 + ch * 8); *(v4u*)(Ow + (long)row * DM + ch * 8) = v; } }
    asm volatile("s_waitcnt vmcnt(0) lgkmcnt(0)\n\ts_barrier" ::: "memory");
#undef DMA_T
}
}
namespace dec {
constexpr int TS = 592, TILE_BYTES = 64 * TS;
constexpr int L_T0 = 0, L_QS = 2 * TILE_BYTES, L_QF = L_QS + 16 * TS, L_END = L_QF + QW * 4;
constexpr int PART_STRIDE = 4096 + 32;

__device__ __forceinline__ void decode_unit(const Params& P, const Ctx& C, int s, int half) {
    unsigned char* ws = P.ws; const bf16* Q = (const bf16*)(ws + WS_Q); const bf16* WKV = (const bf16*)(ws + WS_WKV); float* PART = (float*)(ws + WS_PART); bf16* QLS = (bf16*)(ws + WS_QLS);
    const int r = MP + s, tid = C.tid, lane = C.lane, wave = C.wave, g = lane >> 4, l15 = lane & 15;
    LAS unsigned char* Qs = C.lds + L_QS; LAS float* qf = (LAS float*)(C.lds + L_QF);
    for (int i = tid; i < QW; i += NTHREADS) qf[i] = bf2f(Q[(size_t)r * QW + i]);
    __syncthreads();
    { const int c = tid & 255, hh = tid >> 8;
#pragma unroll 1
      for (int h8 = 0; h8 < 8; ++h8) { const int h = 8 * hh + h8; float acc = 0.f; const bf16* wp = WKV + (size_t)(h * 64) * 256 + c;
#pragma unroll 16
          for (int d = 0; d < 64; ++d) acc += qf[h * 96 + d] * bf2f(wp[(size_t)d * 256]);
          *(LAS bf16*)(Qs + h * TS + c * 2) = (bf16)(cvtpk(acc, 0.f) & 0xffffu); }
      { const int h = tid >> 5, rr = tid & 31, i = rr & 15; const float* tab = (const float*)(ws + WS_ROPE) + SEQ * 16;
        const float x1 = qf[h * 96 + 64 + i], x2 = qf[h * 96 + 80 + i], cc = tab[i], sn = tab[8193 * 16 + i];
        const float o = rr < 16 ? x1 * cc - x2 * sn : x1 * sn + x2 * cc;
        *(LAS bf16*)(Qs + h * TS + (256 + rr) * 2) = (bf16)(cvtpk(o, 0.f) & 0xffffu); } }
    __syncthreads();
    bf16x8 qfr[9];
#pragma unroll
    for (int ks = 0; ks < 9; ++ks) qfr[ks] = *(LAS const bf16x8*)(Qs + l15 * TS + (32 * ks + 8 * g) * 2);
    if (half == 0) { for (int i = tid; i < 16 * 288; i += NTHREADS) { const int h = i / 288, c = i % 288; QLS[(size_t)s * 16 * 288 + i] = *(LAS const bf16*)(Qs + h * TS + c * 2); } }
    const int* pt = P.page_table + s * 64 + 32 * half;
    f32x4 ld[8], ldp;
#define DEC_LOAD(tt) do { const int phys_ = pt[(tt) >> 1]; const size_t krow_ = (size_t)phys_ * 128 + ((tt) & 1) * 64; \
        _Pragma("unroll") for (int i_ = 0; i_ < 8; ++i_) { const int e_ = tid + 512 * i_; ld[i_] = *(const f32x4*)(P.cache_ckv + (krow_ + (e_ >> 6)) * 256 + (e_ & 63) * 4); } \
        ldp = *(const f32x4*)(P.cache_kpe + (krow_ + (tid >> 3)) * 32 + (tid & 7) * 4); } while (0)
#define DEC_STORE(buf) do { LAS unsigned char* b_ = C.lds + (buf) * TILE_BYTES; \
        _Pragma("unroll") for (int i_ = 0; i_ < 8; ++i_) { const int e_ = tid + 512 * i_; u32x2 w_; w_.x = cvtpk(ld[i_][0], ld[i_][1]); w_.y = cvtpk(ld[i_][2], ld[i_][3]); *(LAS u32x2*)(b_ + (e_ >> 6) * TS + (e_ & 63) * 8) = w_; } \
        { u32x2 w_; w_.x = cvtpk(ldp[0], ldp[1]); w_.y = cvtpk(ldp[2], ldp[3]); *(LAS u32x2*)(b_ + (tid >> 3) * TS + 512 + (tid & 7) * 8) = w_; } } while (0)
    float m_run = -1e30f, l_run = 0.f; f32x4 oacc[2]; oacc[0] = (f32x4){0.f, 0.f, 0.f, 0.f}; oacc[1] = (f32x4){0.f, 0.f, 0.f, 0.f};
    DEC_LOAD(0); DEC_STORE(0);
    __syncthreads();
    for (int tt = 0; tt < 64; ++tt) {
        if (tt + 1 < 64) DEC_LOAD(tt + 1);
        const LAS unsigned char* buf = C.lds + (tt & 1) * TILE_BYTES;
        f32x4 sT[4];
#pragma unroll
        for (int kt = 0; kt < 4; ++kt) { sT[kt] = (f32x4){0.f, 0.f, 0.f, 0.f};
#pragma unroll
            for (int ks = 0; ks < 9; ++ks) { const bf16x8 a = *(const LAS bf16x8*)(buf + (16 * kt + l15) * TS + (32 * ks + 8 * g) * 2); sT[kt] = MFMA16(a, qfr[ks], sT[kt]); } }
        float mx = fmaxf(fmaxf(sT[0][0], sT[0][1]), fmaxf(sT[0][2], sT[0][3]));
#pragma unroll
        for (int kt = 1; kt < 4; ++kt) mx = fmaxf(mx, fmaxf(fmaxf(sT[kt][0], sT[kt][1]), fmaxf(sT[kt][2], sT[kt][3])));
        mx = fmaxf(mx, __shfl_xor(mx, 16)); mx = fmaxf(mx, __shfl_xor(mx, 32));
        const float m_new = fmaxf(m_run, mx), alpha = __builtin_amdgcn_exp2f(m_run - m_new); m_run = m_new;
        float sum = 0.f;
#pragma unroll
        for (int kt = 0; kt < 4; ++kt)
#pragma unroll
            for (int i = 0; i < 4; ++i) { const float p = __builtin_amdgcn_exp2f(sT[kt][i] - m_new); sT[kt][i] = p; sum += p; }
        sum += __shfl_xor(sum, 16); sum += __shfl_xor(sum, 32);
        l_run = l_run * alpha + sum;
#pragma unroll
        for (int i = 0; i < 4; ++i) { const float ai = __shfl(alpha, 4 * g + i); oacc[0][i] *= ai; oacc[1][i] *= ai; }
#pragma unroll
        for (int kk = 0; kk < 2; ++kk) { v4u pw; pw.x = cvtpk(sT[2 * kk][0], sT[2 * kk][1]); pw.y = cvtpk(sT[2 * kk][2], sT[2 * kk][3]); pw.z = cvtpk(sT[2 * kk + 1][0], sT[2 * kk + 1][1]); pw.w = cvtpk(sT[2 * kk + 1][2], sT[2 * kk + 1][3]);
            const bf16x8 pa = __builtin_bit_cast(bf16x8, pw);
#pragma unroll
            for (int nt = 0; nt < 2; ++nt) { const int c0 = 32 * wave + 16 * nt; const LAS unsigned char* a0 = buf + (32 * kk + 4 * g + ((lane >> 2) & 3)) * TS + (c0 + 4 * (lane & 3)) * 2;
                const s16x4 lo = vtr(a0), hi = vtr(a0 + 16 * TS);
                const bf16x8 bfr = (bf16x8){lo[0], lo[1], lo[2], lo[3], hi[0], hi[1], hi[2], hi[3]};
                oacc[nt] = MFMA16(pa, bfr, oacc[nt]); } }
        if (tt + 1 < 64) DEC_STORE((tt + 1) & 1);
        __syncthreads();
    }
    float* pp = PART + (size_t)(s * 2 + half) * PART_STRIDE;
#pragma unroll
    for (int nt = 0; nt < 2; ++nt)
#pragma unroll
        for (int i = 0; i < 4; ++i) pp[(4 * g + i) * 256 + 32 * wave + 16 * nt + l15] = oacc[nt][i];
    if (wave == 0 && g == 0) { pp[4096 + l15] = m_run; pp[4112 + l15] = l_run; }
#undef DEC_LOAD
#undef DEC_STORE
}

__device__ __forceinline__ void combine_unit(const Params& P, const Ctx& C, int s) {
    unsigned char* ws = P.ws; const bf16* WKV = (const bf16*)(ws + WS_WKV); const float* PART = (const float*)(ws + WS_PART); const bf16* QLS = (const bf16*)(ws + WS_QLS);
    const bf16* CKV = (const bf16*)(ws + WS_CKV); const bf16* KPE = (const bf16*)(ws + WS_KPE); bf16* ATT = (bf16*)(ws + WS_XN);
    const int r = MP + s, tid = C.tid; LAS float* olat = (LAS float*)C.lds;
    { const int h = tid >> 5, l32 = tid & 31; const bf16* ql = QLS + ((size_t)s * 16 + h) * 288; float sn = 0.f;
#pragma unroll
      for (int k = 0; k < 9; ++k) { const int c = l32 + 32 * k; const float kv = c < 256 ? bf2f(CKV[(size_t)r * 256 + c]) : bf2f(KPE[(size_t)r * 32 + c - 256]); sn += bf2f(ql[c]) * kv; }
      sn += __shfl_xor(sn, 1); sn += __shfl_xor(sn, 2); sn += __shfl_xor(sn, 4); sn += __shfl_xor(sn, 8); sn += __shfl_xor(sn, 16);
      const float* p0 = PART + (size_t)(2 * s) * PART_STRIDE; const float* p1 = p0 + PART_STRIDE;
      const float m0 = p0[4096 + h], l0 = p0[4112 + h], m1 = p1[4096 + h], l1 = p1[4112 + h];
      const float m = fmaxf(fmaxf(m0, m1), sn), w0 = __builtin_amdgcn_exp2f(m0 - m), w1 = __builtin_amdgcn_exp2f(m1 - m), wn = __builtin_amdgcn_exp2f(sn - m);
      const float inv = 1.0f / (w0 * l0 + w1 * l1 + wn);
#pragma unroll
      for (int k = 0; k < 8; ++k) { const int c = l32 + 32 * k; olat[h * 256 + c] = (w0 * p0[h * 256 + c] + w1 * p1[h * 256 + c] + wn * bf2f(CKV[(size_t)r * 256 + c])) * inv; } }
    __syncthreads();
#pragma unroll
    for (int q = 0; q < 2; ++q) { const int n = 2 * tid + q, h = n >> 6; const bf16* wp = WKV + (size_t)(1024 + n) * 256; float acc = 0.f;
#pragma unroll 4
        for (int k = 0; k < 32; ++k) { const v4u w = *(const v4u*)(wp + 8 * k); const f32x4 a = *(LAS const f32x4*)(olat + h * 256 + 8 * k), b = *(LAS const f32x4*)(olat + h * 256 + 8 * k + 4);
            acc += a[0] * bf_lo(w[0]) + a[1] * bf_hi(w[0]) + a[2] * bf_lo(w[1]) + a[3] * bf_hi(w[1]) + b[0] * bf_lo(w[2]) + b[1] * bf_hi(w[2]) + b[2] * bf_lo(w[3]) + b[3] * bf_hi(w[3]); }
        ATT[(size_t)r * DM + n] = (bf16)(cvtpk(acc, 0.f) & 0xffffu); }
    __syncthreads();
}
}
template <int NT, class Epi>
__device__ __forceinline__ void sgemm_units(const Ctx& C, const bf16* A, int lda, const bf16* Bt, int K, int nunits, const Epi& E) {
    const int g = C.lane >> 4, l15 = C.lane & 15, row = 16 * C.wave + l15;
    const bf16* ap = A + (size_t)row * lda + 8 * g;
    for (int u = C.G - 1 - (int)blockIdx.x; u < nunits; u += C.G) {
        f32x4 acc[NT]; const bf16* bp[NT];
#pragma unroll
        for (int nt = 0; nt < NT; ++nt) { acc[nt] = (f32x4){0.f, 0.f, 0.f, 0.f}; bp[nt] = Bt + (size_t)(E.brow(u, nt) + l15) * K + 8 * g; }
#pragma unroll 8
        for (int ks = 0; ks < K / 32; ++ks) { const bf16x8 a = *(const bf16x8*)(ap + 32 * ks);
#pragma unroll
            for (int nt = 0; nt < NT; ++nt) { const bf16x8 b = *(const bf16x8*)(bp[nt] + 32 * ks); acc[nt] = MFMA16(b, a, acc[nt]); } }
        E(u, row, 4 * g, acc);
    }
}
struct SEpiBf16 {
    bf16* O; int ldc;
    __device__ __forceinline__ int brow(int u, int nt) const { return 32 * u + 16 * nt; }
    __device__ __forceinline__ void operator()(int u, int row, int c4, const f32x4 (&acc)[2]) const {
#pragma unroll
        for (int nt = 0; nt < 2; ++nt) { u32x2 w; w.x = cvtpk(acc[nt][0], acc[nt][1]); w.y = cvtpk(acc[nt][2], acc[nt][3]); *(u32x2*)(O + (size_t)(MP + row) * ldc + 32 * u + 16 * nt + c4) = w; }
    }
};
struct SEpiF32 {
    float* O; int ldc;
    __device__ __forceinline__ int brow(int u, int nt) const { return 32 * u + 16 * nt; }
    __device__ __forceinline__ void operator()(int u, int row, int c4, const f32x4 (&acc)[2]) const {
#pragma unroll
        for (int nt = 0; nt < 2; ++nt) *(f32x4*)(O + (size_t)(MP + row) * ldc + 32 * u + 16 * nt + c4) = acc[nt];
    }
};
struct SEpiRes {
    float* X; const float* gate;
    __device__ __forceinline__ int brow(int u, int nt) const { return 16 * u; }
    __device__ __forceinline__ void operator()(int u, int row, int c4, const f32x4 (&acc)[1]) const {
        float* xp = X + (size_t)(MP + row) * DM + 16 * u + c4; const f32x4 gv = *(const f32x4*)(gate + (size_t)row * NMOD + 16 * u + c4);
        *(f32x4*)xp = *(const f32x4*)xp + gv * acc[0];
    }
};
struct SEpiUpConv {
    bf16* U; const float* wc; const float* bc; const float* st; float* oc;
    __device__ __forceinline__ int brow(int u, int nt) const { return (u >> 3) * 256 + (u & 7) * 16 + nt * 128; }
    __device__ __forceinline__ void operator()(int u, int row, int c4, const f32x4 (&acc)[2]) const {
        const int c = 16 * u + c4; const float* sp = st + (size_t)row * 2 * FF + c; float* op = oc + (size_t)row * 2 * FF + c;
        const f32x4 s0 = *(const f32x4*)sp, s1 = *(const f32x4*)(sp + FF), w0 = *(const f32x4*)(wc + c), w1 = *(const f32x4*)(wc + FF + c), w2 = *(const f32x4*)(wc + 2 * FF + c), bb = *(const f32x4*)(bc + c);
        const f32x4 cv = bb + w0 * s0 + w1 * s1 + w2 * acc[0];
        f32x4 o;
#pragma unroll
        for (int e = 0; e < 4; ++e) o[e] = siluf_(cv[e]) * acc[1][e];
        u32x2 w; w.x = cvtpk(o[0], o[1]); w.y = cvtpk(o[2], o[3]); *(u32x2*)(U + (size_t)(MP + row) * FF + c) = w;
        *(f32x4*)op = s1; *(f32x4*)(op + FF) = acc[0];
    }
};

struct EpiUpConv {
    static constexpr bool PERM = true, AFTER_DRAIN = false;
    bf16* U; bf16* HALO; bf16* FIXA; bf16* FIXG; const float* wc; const float* bc;
    __device__ __forceinline__ void operator()(const pg8::f32x4 (&acc)[2][2][4][2], const pg8::Unit& u, int wr, int wcv, int fr, int fq) const {
        const int cc = u.pn * 128 + wcv * 32 + 8 * fq, lane = fq * 16 + fr;
        float w0[8], w1[8], w2[8], bb[8];
#pragma unroll
        for (int q = 0; q < 2; ++q) { const f32x4 a = *(const f32x4*)(wc + cc + 4 * q), b = *(const f32x4*)(wc + FF + cc + 4 * q), c = *(const f32x4*)(wc + 2 * FF + cc + 4 * q), d = *(const f32x4*)(bc + cc + 4 * q);
#pragma unroll
            for (int e = 0; e < 4; ++e) { w0[4 * q + e] = a[e]; w1[4 * q + e] = b[e]; w2[4 * q + e] = c[e]; bb[4 * q + e] = d[e]; } }
        const int src1 = (lane & 48) | ((fr + 15) & 15), src2 = (lane & 48) | ((fr + 14) & 15);
#pragma unroll
        for (int ai = 0; ai < 2; ++ai) {
            float q1[8], q2[8];
#pragma unroll
            for (int e = 0; e < 8; ++e) { q1[e] = 0.f; q2[e] = 0.f; }
#pragma unroll
            for (int m = 0; m < 4; ++m) {
                const int row = u.pm * 256 + ai * 128 + wr * 64 + m * 16 + fr, blk = row >> 6;
                float a[8], gt[8], o[8];
#pragma unroll
                for (int e = 0; e < 8; ++e) { a[e] = acc[ai][0][m][e >> 2][e & 3]; gt[e] = acc[ai][1][m][e >> 2][e & 3]; }
#pragma unroll
                for (int e = 0; e < 8; ++e) { const float r1 = __shfl(a[e], src1), r2 = __shfl(a[e], src2);
                    const float x1 = fr >= 1 ? r1 : q1[e], x2 = fr >= 2 ? r2 : q2[e]; q1[e] = r1; q2[e] = r2;
                    const float cv = bb[e] + w0[e] * x2 + w1[e] * x1 + w2[e] * a[e]; o[e] = siluf_(cv) * gt[e]; }
                pg8::u32x4 wa; wa.x = cvtpk(a[0], a[1]); wa.y = cvtpk(a[2], a[3]); wa.z = cvtpk(a[4], a[5]); wa.w = cvtpk(a[6], a[7]);
                if (m == 0 && fr < 2) { pg8::u32x4 wg; wg.x = cvtpk(gt[0], gt[1]); wg.y = cvtpk(gt[2], gt[3]); wg.z = cvtpk(gt[4], gt[5]); wg.w = cvtpk(gt[6], gt[7]);
                    *(pg8::u32x4*)(FIXA + (size_t)(blk * 2 + fr) * FF + cc) = wa; *(pg8::u32x4*)(FIXG + (size_t)(blk * 2 + fr) * FF + cc) = wg; }
                else { pg8::u32x4 wo; wo.x = cvtpk(o[0], o[1]); wo.y = cvtpk(o[2], o[3]); wo.z = cvtpk(o[4], o[5]); wo.w = cvtpk(o[6], o[7]); *(pg8::u32x4*)(U + (size_t)row * FF + cc) = wo; }
                if (m == 3 && fr >= 14) *(pg8::u32x4*)(HALO + (size_t)(blk * 2 + fr - 14) * FF + cc) = wa;
            }
        }
    }
};
__device__ __forceinline__ void conv_fixup(const Params& P, const Ctx& C, int layer) {
    unsigned char* ws = P.ws; bf16* U = (bf16*)(ws + WS_U); const bf16* HALO = (const bf16*)(ws + WS_HALO); const bf16* FIXA = (const bf16*)(ws + WS_FIXA); const bf16* FIXG = (const bf16*)(ws + WS_FIXG);
    const float* wc = P.w_conv + (size_t)layer * 3 * FF; const float* bc = P.b_conv + (size_t)layer * FF;
    const int gt_ = C.vcu * NTHREADS + C.tid, NGT = C.G * NTHREADS; constexpr int NCH = FF / 8;
    for (int it = gt_; it < 512 * NCH; it += NGT) {
        const int rj = it / NCH, ch = it % NCH, c0 = ch * 8, blk = rj >> 1, j = rj & 1, row = blk * 64 + j; const bool first = (blk & 127) == 0;
        const v4u ta = *(const v4u*)(FIXA + (size_t)rj * FF + c0), tg = *(const v4u*)(FIXG + (size_t)rj * FF + c0);
        v4u t1 = {0u, 0u, 0u, 0u}, t2 = {0u, 0u, 0u, 0u};
        if (j == 1) { t1 = *(const v4u*)(FIXA + (size_t)(rj - 1) * FF + c0); if (!first) t2 = *(const v4u*)(HALO + (size_t)((blk - 1) * 2 + 1) * FF + c0); }
        else if (!first) { t1 = *(const v4u*)(HALO + (size_t)((blk - 1) * 2 + 1) * FF + c0); t2 = *(const v4u*)(HALO + (size_t)((blk - 1) * 2) * FF + c0); }
        float o[8];
#pragma unroll
        for (int e = 0; e < 8; ++e) { const int q = e >> 1; const float a = (e & 1) ? bf_hi(ta[q]) : bf_lo(ta[q]), g = (e & 1) ? bf_hi(tg[q]) : bf_lo(tg[q]), x1 = (e & 1) ? bf_hi(t1[q]) : bf_lo(t1[q]), x2 = (e & 1) ? bf_hi(t2[q]) : bf_lo(t2[q]);
            const float cv = bc[c0 + e] + wc[c0 + e] * x2 + wc[FF + c0 + e] * x1 + wc[2 * FF + c0 + e] * a; o[e] = siluf_(cv) * g; }
        v4u w; w.x = cvtpk(o[0], o[1]); w.y = cvtpk(o[2], o[3]); w.z = cvtpk(o[4], o[5]); w.w = cvtpk(o[6], o[7]);
        *(v4u*)(U + (size_t)row * FF + c0) = w;
    }
    for (int it = gt_; it < 4 * NCH; it += NGT) {
        const int bj = it / NCH, ch = it % NCH, c0 = ch * 8, b = bj >> 1, j = bj & 1;
        const v4u t = *(const v4u*)(HALO + (size_t)((128 * b + 127) * 2 + j) * FF + c0); float* oc = P.out + O_CONVP + ((size_t)(layer * 2 + b) * 2 + j) * FF + c0;
        *(f32x4*)oc = (f32x4){bf_lo(t[0]), bf_hi(t[0]), bf_lo(t[1]), bf_hi(t[1])}; *(f32x4*)(oc + 4) = (f32x4){bf_lo(t[2]), bf_hi(t[2]), bf_lo(t[3]), bf_hi(t[3])};
    }
}
#ifndef MK_ONE_LAUNCH
#define MK_ONE_LAUNCH 1
#endif
constexpr int N_PHASES = 25;
__global__ void __launch_bounds__(NTHREADS, 2) mk_fwd(Params P) {
    extern __shared__ __attribute__((aligned(16))) unsigned char lds_raw[];
    Ctx C;
    C.lds = (LAS unsigned char*)lds_raw;
    C.tid = threadIdx.x; C.lane = C.tid & 63; C.wave = __builtin_amdgcn_readfirstlane(C.tid >> 6);
    C.G = gridDim.x; { const int bx = blockIdx.x; C.vcu = (C.G % 8 == 0) ? (bx % 8) * (C.G / 8) + bx / 8 : bx; }
    C.gw = C.vcu * NWAVES + C.wave; C.NGW = C.G * NWAVES;
    unsigned char* ws = P.ws;
    volatile LAS unsigned* MISC = (volatile LAS unsigned*)(C.lds + MISC_OFF);
    for (int u = C.tid; u < (LDS_BYTES - LDSCTL_OFF) / 4; u += NTHREADS) ((LAS unsigned*)(C.lds + LDSCTL_OFF))[u] = 0u;
    __syncthreads();
    XcdBarrier bar; bar.bar = (unsigned*)(ws + WS_CTL) + CW_BAR; bar.x = 0; bar.st = nullptr;
    if (MK_ONE_LAUNCH) bar = xcd_barrier_post((unsigned*)(ws + WS_CTL) + CW_BAR, MISC + 8);
    const int lo = P.ph_lo, hi = P.ph_hi;
#ifdef ONLY_PHASE
#define IN(k) (((k) == ONLY_PHASE) && lo <= (k) && (k) < hi)
#else
#define IN(k) (lo <= (k) && (k) < hi)
#endif
#ifndef PROBE_MASK
#define PROBE_MASK 0u
#endif
#define REP(k) for (int rep_ = 0; rep_ < ((((unsigned)PROBE_MASK >> (k)) & 1u) ? 2 : 1); ++rep_)
#define SEAM(k) do { if (MK_ONE_LAUNCH && IN(k) && IN((k) + 1)) xcd_barrier(bar); } while (0)
    LAS unsigned char* ring = C.lds + RING_OFF;
    const float* MOD = (const float*)(ws + WS_MOD); float* X = (float*)(ws + WS_X);
    bf16* XN = (bf16*)(ws + WS_XN); bf16* XN2 = (bf16*)(ws + WS_XN2);

    if (IN(0)) REP(0) { p0_prologue(P, C); } SEAM(0);
    if (IN(1)) REP(1) { pg8::Gemm g{(const bf16*)(ws + WS_AMOD), (const bf16*)(ws + WS_WMOD), 256, NMOD, DM}; pg8::StaticOrder S; S.init(256, NMOD, C.G, (int)blockIdx.x);
        EpiMod E{(float*)(ws + WS_MOD), P.b_ada, P.b_ada_kv};
        pg8::gemm_phase<EpiMod, pg8::StaticOrder, false, true>(ring, g, S, E); } SEAM(1);
    if (IN(2)) REP(2) { p2_norm_in(P, C); } SEAM(2);
    if (IN(3)) REP(3) { pg8::Gemm g{XN, (const bf16*)(ws + WS_WIN), MP, NIN, DM}; pg8::StaticOrder S; S.init(MP, NIN, C.G, (int)blockIdx.x);
        pg8::EpiBf16<0> E{(bf16*)(ws + WS_QKVO), NIN, nullptr, 0, 0, 1.f};
        pg8::gemm_phase<pg8::EpiBf16<0>, pg8::StaticOrder, true, true>(ring, g, S, E);
        SEpiBf16 SE{(bf16*)(ws + WS_QKVO), NIN}; sgemm_units<2>(C, XN + (size_t)MP * DM, DM, (const bf16*)(ws + WS_WIN), DM, NIN / 32, SE); } SEAM(3);
    if (IN(4)) REP(4) { for (int u = C.vcu; u < 1024 + 512; u += C.G) { if (u < 1024) m1_unit(P, C, u >> 7, u & 127); else mstep_unit(P, C, (u - 1024) >> 2, (u - 1024) & 3); } } SEAM(4);
    if (IN(5)) REP(5) { m2_scan(P, C); } SEAM(5);
    if (IN(6)) REP(6) { for (int u = C.vcu; u < 1024; u += C.G) m3_unit(P, C, u >> 7, u & 127); } SEAM(6);
    if (IN(7)) REP(7) { pg8::Gemm g{XN, (const bf16*)(ws + WS_WOUT), MP, DM, DM}; pg8::StaticOrder S; S.init(MP, DM, C.G, (int)blockIdx.x);
        EpiRes E{X, MOD + 2048};
        pg8::gemm_phase<EpiRes, pg8::StaticOrder, true, true>(ring, g, S, E);
        SEpiRes SE{X, MOD + 2048}; sgemm_units<1>(C, XN + (size_t)MP * DM, DM, (const bf16*)(ws + WS_WOUT), DM, DM / 16, SE); } SEAM(7);
    if (IN(8)) REP(8) { norm_rows(P, C, P.g_norm2, 4096, 3072, XN, nullptr, 0, 0, nullptr); } SEAM(8);
    if (IN(9)) REP(9) { pg8::Gemm g{XN, (const bf16*)(ws + WS_WUP), MP, FF2, DM}; pg8::StaticOrder S; S.init(MP, FF2, C.G, (int)blockIdx.x);
        EpiUpConv E{(bf16*)(ws + WS_U), (bf16*)(ws + WS_HALO), (bf16*)(ws + WS_FIXA), (bf16*)(ws + WS_FIXG), P.w_conv + (size_t)0 * 3 * FF, P.b_conv + (size_t)0 * FF};
        pg8::gemm_phase<EpiUpConv, pg8::StaticOrder, true, true>(ring, g, S, E);
        SEpiUpConv SE{(bf16*)(ws + WS_U), P.w_conv + (size_t)0 * 3 * FF, P.b_conv + (size_t)0 * FF, P.st_conv + (size_t)0 * NS * 2 * FF, P.out + O_CONVS + (size_t)0 * NS * 2 * FF};
        sgemm_units<2>(C, XN + (size_t)MP * DM, DM, (const bf16*)(ws + WS_WUP), DM, FF / 16, SE); } SEAM(9);
    if (IN(10)) REP(10) { conv_fixup(P, C, 0); } SEAM(10);
    if (IN(11)) REP(11) { pg8::Gemm g{(const bf16*)(ws + WS_U), (const bf16*)(ws + WS_WDOWN), MP, DM, FF}; pg8::StaticOrder S; S.init(MP, DM, C.G, (int)blockIdx.x);
        EpiRes E{X, MOD + 5120};
        pg8::gemm_phase<EpiRes, pg8::StaticOrder, true, true>(ring, g, S, E);
        SEpiRes SE{X, MOD + 5120}; sgemm_units<1>(C, (const bf16*)(ws + WS_U) + (size_t)MP * FF, FF, (const bf16*)(ws + WS_WDOWN), FF, DM / 16, SE); } SEAM(11);
    if (IN(12)) REP(12) { norm_rows(P, C, P.g_norm1 + DM, 7168, 6144, XN, P.g_kv_in, 13312, 12288, XN2); } SEAM(12);
    if (IN(13)) REP(13) {
        { pg8::Gemm g{XN2, (const bf16*)(ws + WS_WDKV), MP, 512, DM}; pg8::StaticOrder S; S.init(MP, 512, C.G, (int)blockIdx.x);
          EpiF32 E{(float*)(ws + WS_LAT), 512}; pg8::gemm_phase<EpiF32, pg8::StaticOrder, true, true>(ring, g, S, E); }
        { pg8::Gemm g{XN, (const bf16*)(ws + WS_WDQ), MP, 512, DM}; pg8::StaticOrder S; S.init(MP, 512, C.G, ((int)blockIdx.x + C.G / 2) % C.G);
          EpiF32 E{(float*)(ws + WS_QLAT), 512}; pg8::gemm_phase<EpiF32, pg8::StaticOrder, true, true>(ring, g, S, E); }
        { SEpiF32 SE{(float*)(ws + WS_LAT), 512}; sgemm_units<2>(C, XN2 + (size_t)MP * DM, DM, (const bf16*)(ws + WS_WDKV), DM, 288 / 32, SE); }
        { SEpiF32 SE{(float*)(ws + WS_QLAT), 512}; sgemm_units<2>(C, XN + (size_t)MP * DM, DM, (const bf16*)(ws + WS_WDQ), DM, 384 / 32, SE); } } SEAM(13);
    if (IN(14)) REP(14) { latent_rows(P, C); } SEAM(14);
    if (IN(15)) REP(15) {
        { pg8::Gemm g{(const bf16*)(ws + WS_QN), (const bf16*)(ws + WS_WUQ), MP, QW, 384}; pg8::StaticOrder S; S.init(MP, QW, C.G, (int)blockIdx.x);
          pg8::EpiBf16<0> E{(bf16*)(ws + WS_Q), QW, nullptr, 0, 0, 1.f}; pg8::gemm_phase<pg8::EpiBf16<0>, pg8::StaticOrder, true, true>(ring, g, S, E); }
        { pg8::Gemm g{(const bf16*)(ws + WS_CKV), (const bf16*)(ws + WS_WKV), MP, 2048, 256}; pg8::StaticOrder S; S.init(MP, 2048, C.G, ((int)blockIdx.x + C.G / 2) % C.G);
          pg8::EpiBf16<0> E{(bf16*)(ws + WS_KN), DM, nullptr, 1024, (size_t)(WS_V - WS_KN) / 2, 1.f}; pg8::gemm_phase<pg8::EpiBf16<0>, pg8::StaticOrder, true, true>(ring, g, S, E); }
        { SEpiBf16 SE{(bf16*)(ws + WS_Q), QW}; sgemm_units<2>(C, (const bf16*)(ws + WS_QN) + (size_t)MP * 384, 384, (const bf16*)(ws + WS_WUQ), 384, QW / 32, SE); } } SEAM(15);
    if (IN(16)) REP(16) {
        const bf16* Qb = (const bf16*)(ws + WS_Q); const bf16* KNb = (const bf16*)(ws + WS_KN); const bf16* KPb = (const bf16*)(ws + WS_KPE); const bf16* Vb = (const bf16*)(ws + WS_V);
        if (C.G == 256) { const int bhh = C.vcu >> 3, s = C.vcu & 7;
            for (int i = 0; i < 4; ++i) { const int qb = (i == 0) ? s : (i == 1) ? 15 - s : (i == 2) ? 16 + s : 31 - s; att::attn_unit(bhh >> 4, bhh & 15, qb, Qb, KNb, KPb, Vb, XN, (const float*)(ws + WS_ROPE), ring); } }
        else { for (int u = C.vcu; u < 1024; u += C.G) att::attn_unit(u >> 9, (u >> 5) & 15, u & 31, Qb, KNb, KPb, Vb, XN, (const float*)(ws + WS_ROPE), ring); } } SEAM(16);
    if (IN(17)) REP(17) { for (int u = C.vcu; u < 256; u += C.G) dec::decode_unit(P, C, u >> 1, u & 1); } SEAM(17);
    if (IN(18)) REP(18) { for (int u = C.vcu; u < NS; u += C.G) dec::combine_unit(P, C, u); } SEAM(18);
    if (IN(19)) REP(19) { pg8::Gemm g{XN, (const bf16*)(ws + WS_WO), MP, DM, DM}; pg8::StaticOrder S; S.init(MP, DM, C.G, (int)blockIdx.x);
        EpiRes E{X, MOD + 8192};
        pg8::gemm_phase<EpiRes, pg8::StaticOrder, true, true>(ring, g, S, E);
        SEpiRes SE{X, MOD + 8192}; sgemm_units<1>(C, XN + (size_t)MP * DM, DM, (const bf16*)(ws + WS_WO), DM, DM / 16, SE); } SEAM(19);
    if (IN(20)) REP(20) { norm_rows(P, C, P.g_norm2 + DM, 10240, 9216, XN, nullptr, 0, 0, nullptr); } SEAM(20);
    if (IN(21)) REP(21) { pg8::Gemm g{XN, (const bf16*)(ws + WS_WUP) + (size_t)FF2 * DM, MP, FF2, DM}; pg8::StaticOrder S; S.init(MP, FF2, C.G, (int)blockIdx.x);
        EpiUpConv E{(bf16*)(ws + WS_U), (bf16*)(ws + WS_HALO), (bf16*)(ws + WS_FIXA), (bf16*)(ws + WS_FIXG), P.w_conv + (size_t)1 * 3 * FF, P.b_conv + (size_t)1 * FF};
        pg8::gemm_phase<EpiUpConv, pg8::StaticOrder, true, true>(ring, g, S, E);
        SEpiUpConv SE{(bf16*)(ws + WS_U), P.w_conv + (size_t)1 * 3 * FF, P.b_conv + (size_t)1 * FF, P.st_conv + (size_t)1 * NS * 2 * FF, P.out + O_CONVS + (size_t)1 * NS * 2 * FF};
        sgemm_units<2>(C, XN + (size_t)MP * DM, DM, (const bf16*)(ws + WS_WUP) + (size_t)FF2 * DM, DM, FF / 16, SE); } SEAM(21);
    if (IN(22)) REP(22) { conv_fixup(P, C, 1); } SEAM(22);
    if (IN(23)) REP(23) { pg8::Gemm g{(const bf16*)(ws + WS_U), (const bf16*)(ws + WS_WDOWN) + (size_t)DM * FF, MP, DM, FF}; pg8::StaticOrder S; S.init(MP, DM, C.G, (int)blockIdx.x);
        EpiRes E{X, MOD + 11264};
        pg8::gemm_phase<EpiRes, pg8::StaticOrder, true, true>(ring, g, S, E);
        SEpiRes SE{X, MOD + 11264}; sgemm_units<1>(C, (const bf16*)(ws + WS_U) + (size_t)MP * FF, FF, (const bf16*)(ws + WS_WDOWN) + (size_t)DM * FF, FF, DM / 16, SE); } SEAM(23);
    if (IN(24)) REP(24) { final_norm(P, C); }
#undef IN
#undef SEAM
}

extern "C" void kernel_launch(void* const* d_in, const int* in_sizes, int n_in, void* d_out, int out_size, void* d_ws, size_t ws_size, hipStream_t stream) {
    static int grid = 0;
    if (grid == 0) {
        if (n_in != 35 || out_size != (int)O_END || ws_size < WS_END) { fprintf(stderr, "kernel_launch: unexpected shapes (n_in %d, out %d, ws %zu < %zu); nothing launched\n", n_in, out_size, ws_size, (size_t)WS_END); grid = -1; return; }
        int dev = 0, cus = 0, per_cu = 0;
        if (hipGetDevice(&dev) != hipSuccess || hipDeviceGetAttribute(&cus, hipDeviceAttributeMultiprocessorCount, dev) != hipSuccess) { grid = -1; return; }
        if (hipFuncSetAttribute((const void*)mk_fwd, hipFuncAttributeMaxDynamicSharedMemorySize, LDS_BYTES) != hipSuccess) { fprintf(stderr, "kernel_launch: hipFuncSetAttribute failed\n"); grid = -1; return; }
        if (hipOccupancyMaxActiveBlocksPerMultiprocessor(&per_cu, (const void*)mk_fwd, NTHREADS, LDS_BYTES) != hipSuccess || per_cu < 1)
            fprintf(stderr, "kernel_launch: note: occupancy query reports %d workgroups per CU\n", per_cu);
        (void)hipGetLastError();
        grid = cus;
    }
    if (grid < 0) return;
    if (hipMemsetAsync((char*)d_ws + WS_CTL, 0, CTL_ZERO_BYTES, stream) != hipSuccess) { fprintf(stderr, "kernel_launch: memset failed\n"); return; }
    Params p{};
    p.x_p = (const float*)d_in[0]; p.x_s = (const float*)d_in[1]; p.st_C = (const float*)d_in[2]; p.st_n = (const float*)d_in[3]; p.st_m = (const float*)d_in[4]; p.st_conv = (const float*)d_in[5];
    p.cache_ckv = (const float*)d_in[6]; p.cache_kpe = (const float*)d_in[7]; p.page_table = (const int*)d_in[8]; p.c_p = (const float*)d_in[9]; p.c_s = (const float*)d_in[10];
    p.g_norm1 = (const float*)d_in[11]; p.g_norm2 = (const float*)d_in[12]; p.w_ada = (const float*)d_in[13]; p.b_ada = (const float*)d_in[14]; p.w_up = (const float*)d_in[15];
    p.w_conv = (const float*)d_in[16]; p.b_conv = (const float*)d_in[17]; p.w_down = (const float*)d_in[18]; p.w_m_in = (const float*)d_in[19]; p.b_m_gates = (const float*)d_in[20];
    p.g_m_head = (const float*)d_in[21]; p.w_m_out = (const float*)d_in[22]; p.g_kv_in = (const float*)d_in[23]; p.w_ada_kv = (const float*)d_in[24]; p.b_ada_kv = (const float*)d_in[25];
    p.w_dkv = (const float*)d_in[26]; p.g_kv = (const float*)d_in[27]; p.w_uk = (const float*)d_in[28]; p.w_uv = (const float*)d_in[29]; p.w_dq = (const float*)d_in[30];
    p.g_q = (const float*)d_in[31]; p.w_uq = (const float*)d_in[32]; p.w_o = (const float*)d_in[33]; p.g_final = (const float*)d_in[34];
    p.out = (float*)d_out; p.ws = (unsigned char*)d_ws;
#if MK_ONE_LAUNCH
    p.ph_lo = 0; p.ph_hi = N_PHASES;
    hipLaunchKernelGGL(mk_fwd, dim3(grid), dim3(NTHREADS), LDS_BYTES, stream, p);
#else
    for (int ph = 0; ph < N_PHASES; ++ph) { p.ph_lo = ph; p.ph_hi = ph + 1; hipLaunchKernelGGL(mk_fwd, dim3(grid), dim3(NTHREADS), LDS_BYTES, stream, p); }
#endif
    const hipError_t le = hipPeekAtLastError();
    if (le != hipSuccess) fprintf(stderr, "kernel_launch: launch failed: %s\n", hipGetErrorName(le));
}
```

```cpp
#include <hip/hip_runtime.h>
#include <hip/hip_bf16.h>
#include <cstdio>
#include <cstdint>
#include <cmath>
namespace pg8 {
#define PG8_LAS __attribute__((address_space(3)))
typedef unsigned short bf16_t;
typedef short bf16x8 __attribute__((ext_vector_type(8)));
typedef float f32x4 __attribute__((ext_vector_type(4)));
typedef unsigned u32x4 __attribute__((ext_vector_type(4)));
constexpr int BM = 256, BK = 64, HALF = 128, HTB = HALF * BK * 2  , STAGE_BYTES = 8 * HTB, NXCD = 8, WGM = 8;

__host__ __device__ __forceinline__ int lds_byte(int r, int c) { const int st = (r >> 4) * 2 + (c >> 5), rr = r & 15, cc = c & 31, ob = rr * 64 + cc * 2; return st * 1024 + (ob ^ (((ob >> 9) & 1) << 5)); }
__host__ __device__ __forceinline__ void stage_rc(int b, int& R, int& C) { const int st = b / 1024, sb = b % 1024, swz = sb ^ (((sb >> 9) & 1) << 5); R = (st >> 1) * 16 + swz / 64; C = (st & 1) * 32 + (swz % 64) / 2; }
__host__ __device__ __forceinline__ int perm32(int rho) { const int n = rho >> 4, i = rho & 15; return 8 * (i >> 2) + 4 * n + (i & 3); }

struct Unit { int pm, pn; };
struct Gemm { const bf16_t* A; const bf16_t* Bt; int M, N, K; };

struct StaticOrder {
    int nM, nN, nwg, G, c;
    __host__ __device__ void init(int M, int N, int G_, int c_) { nM = M / BM; nN = N / BM; nwg = nM * nN; G = G_; c = c_; }
    __host__ __device__ bool next(int i, Unit& u) const {
        const long L = (long)i * G + c; if (L >= nwg) return false;
        int wgid = (int)L; { const int q = nwg / NXCD, r = nwg % NXCD, xcd = wgid % NXCD, off = wgid / NXCD; wgid = (xcd < r ? xcd * (q + 1) : r * (q + 1) + (xcd - r) * q) + off; }
        const int nig = WGM * nN, gid = wgid / nig, fm = gid * WGM, gsz = (nM - fm) < WGM ? (nM - fm) : WGM;
        u.pm = fm + ((wgid % nig) % gsz); u.pn = (wgid % nig) / gsz; return true;
    }
    __device__ __forceinline__ void a_ready(const Unit&) const {}
    __device__ __forceinline__ void done(const Unit&) const {}
};

__device__ __forceinline__ unsigned cvt_pk_bf16(float lo, float hi) { unsigned r; asm volatile("v_cvt_pk_bf16_f32 %0, %1, %2" : "=v"(r) : "v"(lo), "v"(hi)); return r; }
typedef float f32x2 __attribute__((ext_vector_type(2)));
__device__ __forceinline__ f32x2 gelu_pk(f32x2 v) {
    const f32x2 av = __builtin_elementwise_abs(v), d = av * 0.2316418882f + 1.0f;
    f32x2 t; t.x = __builtin_amdgcn_rcpf(d.x); t.y = __builtin_amdgcn_rcpf(d.y);
    f32x2 q = t * 0.5307027145f + (-0.7265760135f); q = q * t + 0.7107068705f; q = q * t + (-0.142248368f); q = q * t + 0.127414796f; q = q * t;
    const f32x2 s = (v * v) * (-0.72134752044f);
    f32x2 e; e.x = __builtin_amdgcn_exp2f(s.x); e.y = __builtin_amdgcn_exp2f(s.y);
    const f32x2 m = v * (q * e), r = v - m;
    f32x2 o; o.x = v.x < 0.f ? m.x : r.x; o.y = v.y < 0.f ? m.y : r.y; return o;
}

template <int ACT  > struct EpiBf16 {
    static constexpr bool PERM = true, AFTER_DRAIN = false; static_assert(ACT == 0 || ACT == 1, "EpiBf16: ACT is 0 (none) or 1 (gelu_pk)");
    bf16_t* O; int ldc; const float* bias; int split_cols; size_t split_stride; float scale0;
    __device__ __forceinline__ void operator()(const f32x4 (&acc)[2][2][4][2], const Unit& u, int wr, int wc, int fr, int fq) const {
        const int row0 = u.pm * BM + wr * 64 + fr; int colt = u.pn * BM; bf16_t* base = O;
        float sc = 1.f; if (split_cols) { const int t = colt / split_cols; base += (size_t)t * split_stride; colt -= t * split_cols; if (t == 0) sc = scale0; }
        const int col0 = colt + wc * 32 + 8 * fq, bcol0 = u.pn * BM + wc * 32 + 8 * fq;
        f32x4 bv[2][2];
#pragma unroll
        for (int bj = 0; bj < 2; ++bj)
#pragma unroll
            for (int n = 0; n < 2; ++n) bv[bj][n] = bias ? *(const f32x4*)(bias + bcol0 + bj * HALF + 4 * n) : (f32x4){0.f, 0.f, 0.f, 0.f};
#pragma unroll
        for (int ai = 0; ai < 2; ++ai)
#pragma unroll
            for (int m = 0; m < 4; ++m) { bf16_t* rowp = base + (size_t)(row0 + ai * HALF + m * 16) * ldc + col0;
#pragma unroll
                for (int bj = 0; bj < 2; ++bj) { f32x4 v0 = acc[ai][bj][m][0] + bv[bj][0], v1 = acc[ai][bj][m][1] + bv[bj][1];
                    if (ACT == 1) { f32x2 a = gelu_pk((f32x2){v0[0], v0[1]}), b = gelu_pk((f32x2){v0[2], v0[3]}), c = gelu_pk((f32x2){v1[0], v1[1]}), d = gelu_pk((f32x2){v1[2], v1[3]});
                        v0 = (f32x4){a.x, a.y, b.x, b.y}; v1 = (f32x4){c.x, c.y, d.x, d.y}; }
                    v0 = v0 * sc; v1 = v1 * sc; u32x4 w; w.x = cvt_pk_bf16(v0[0], v0[1]); w.y = cvt_pk_bf16(v0[2], v0[3]); w.z = cvt_pk_bf16(v1[0], v1[1]); w.w = cvt_pk_bf16(v1[2], v1[3]);
                    *(u32x4*)(rowp + bj * HALF) = w; } }
    }
};

struct PanelStats {
    unsigned* xbuf;
    unsigned* cnt;
    unsigned* tmo;
    int ntn; float eps;
    unsigned code;
    __device__ __forceinline__ bool run(const f32x4 (&v)[2][2][4][2], const Unit& u, int wr, int wc, int fr, int fq, PG8_LAS unsigned char* lds, int wid, int lane) const {
        typedef float f32x2v __attribute__((ext_vector_type(2)));
        PG8_LAS f32x2v* P = (PG8_LAS f32x2v*)lds;
        PG8_LAS f32x2v* S = (PG8_LAS f32x2v*)(lds + 8192);
        PG8_LAS unsigned* flag = (PG8_LAS unsigned*)(lds + 8192 + 2048);
#pragma unroll
        for (int ai = 0; ai < 2; ++ai)
#pragma unroll
            for (int m = 0; m < 4; ++m) {
                float s = 0.f;
#pragma unroll
                for (int bj = 0; bj < 2; ++bj)
#pragma unroll
                    for (int n = 0; n < 2; ++n) { const f32x4 x = v[ai][bj][m][n]; s += (x[0] + x[1]) + (x[2] + x[3]); }
                s += __shfl_xor(s, 16); s += __shfl_xor(s, 32);
                const float mw = s * (1.0f / 64.0f); float q = 0.f;
#pragma unroll
                for (int bj = 0; bj < 2; ++bj)
#pragma unroll
                    for (int n = 0; n < 2; ++n) { const f32x4 d = v[ai][bj][m][n] - mw; q += (d[0] * d[0] + d[1] * d[1]) + (d[2] * d[2] + d[3] * d[3]); }
                q += __shfl_xor(q, 16); q += __shfl_xor(q, 32);
                if (fq == 0) P[(ai * HALF + wr * 64 + m * 16 + fr) * 4 + wc] = (f32x2v){mw, q};
            }
        asm volatile("s_waitcnt lgkmcnt(0)" ::: "memory"); __builtin_amdgcn_s_barrier(); asm volatile("" ::: "memory");
#if defined(BROKEN_EXCHANGE_NO_WAIT)
#warning BROKEN CONTROL BUILD: the row-statistics exchange does not wait; results are wrong by design
        if (blockIdx.x >= 64) { const long long t0_ = clock64(); while (clock64() - t0_ < 60000) __builtin_amdgcn_s_sleep(8); }
#endif
        const int row = wid * 32 + (lane & 31);
        if (lane < 32) {
            const f32x2v a = P[row * 4 + 0], b = P[row * 4 + 1], c = P[row * 4 + 2], d = P[row * 4 + 3];
            const float mt = (a.x + b.x + c.x + d.x) * 0.25f;
            const float da = a.x - mt, db = b.x - mt, dc = c.x - mt, dd = d.x - mt;
            const float m2 = (a.y + b.y) + (c.y + d.y) + 64.0f * ((da * da + db * db) + (dc * dc + dd * dd));
            unsigned long long* slot = (unsigned long long*)xbuf + ((size_t)(u.pm * BM + row) * 4 + u.pn);
            __hip_atomic_store(slot, ((unsigned long long)__float_as_uint(m2) << 32) | __float_as_uint(mt), __ATOMIC_RELAXED, __HIP_MEMORY_SCOPE_AGENT);
        }
        asm volatile("s_waitcnt vmcnt(0)" ::: "memory");
        if (lane == 0) __hip_atomic_fetch_add(cnt + 64 * u.pm, 1u, __ATOMIC_RELAXED, __HIP_MEMORY_SCOPE_AGENT);
        if (wid == 0) {
            bool dead = false; const unsigned long long t0 = __builtin_amdgcn_s_memrealtime(); const unsigned want = 8u * (unsigned)ntn;
            for (;;) {
#if defined(BROKEN_EXCHANGE_NO_WAIT)
                break;
#endif
                if ((unsigned)__builtin_amdgcn_readfirstlane(__hip_atomic_load(cnt + 64 * u.pm, __ATOMIC_RELAXED, __HIP_MEMORY_SCOPE_AGENT)) >= want) break;
                if (__builtin_amdgcn_s_memrealtime() - t0 > 2000000ull) {
                    if (lane == 0) { unsigned expect = 0u; __hip_atomic_compare_exchange_strong(tmo + 1, &expect, code | (unsigned)(u.pm & 0xff), __ATOMIC_RELAXED, __ATOMIC_RELAXED, __HIP_MEMORY_SCOPE_AGENT);
                                     __hip_atomic_store(tmo, 1u, __ATOMIC_RELAXED, __HIP_MEMORY_SCOPE_AGENT); }
                    dead = true; break; }
                __builtin_amdgcn_s_sleep(2);
            }
            __builtin_amdgcn_fence(__ATOMIC_ACQUIRE, "agent");
            if (lane == 0) flag[0] = dead ? 1u : 0u;
        }
        asm volatile("s_waitcnt vmcnt(0) lgkmcnt(0)" ::: "memory"); __builtin_amdgcn_s_barrier(); asm volatile("" ::: "memory");
        const bool bad = flag[0] != 0u;
        if (lane < 32) {
            const unsigned long long* slot = (const unsigned long long*)xbuf + (size_t)(u.pm * BM + row) * 4; float mt[4], m2[4]; float ms = 0.f;
#pragma unroll
            for (int t = 0; t < 4; ++t) { if (t < ntn) { const unsigned long long w = __hip_atomic_load(slot + t, __ATOMIC_RELAXED, __HIP_MEMORY_SCOPE_AGENT); mt[t] = __uint_as_float((unsigned)w); m2[t] = __uint_as_float((unsigned)(w >> 32)); } else { mt[t] = 0.f; m2[t] = 0.f; } ms += mt[t]; }
            const float mean = ms / (float)ntn; float q = 0.f;
#pragma unroll
            for (int t = 0; t < 4; ++t) if (t < ntn) { const float dm = mt[t] - mean; q += m2[t] + 256.0f * dm * dm; }
            S[row] = (f32x2v){mean, 1.0f / sqrtf(q / (256.0f * (float)ntn) + eps)};
        }
        asm volatile("s_waitcnt lgkmcnt(0)" ::: "memory"); __builtin_amdgcn_s_barrier(); asm volatile("" ::: "memory");
        return bad;
    }
};
struct EpiLnRes {
    static constexpr bool PERM = false, AFTER_DRAIN = true;
    const float* base; float* out; int ldc; const float* bias; PanelStats st; unsigned poison;
    __device__ __forceinline__ void fused(f32x4 (&acc)[2][2][4][2], const Unit& u, int wr, int wc, int fr, int fq, PG8_LAS unsigned char* lds, int wid, int lane) const {
        typedef float f32x2v __attribute__((ext_vector_type(2)));
        const PG8_LAS f32x2v* S = (const PG8_LAS f32x2v*)(lds + 8192);
        const int col0 = u.pn * BM + wc * 32 + 4 * fq;
#pragma unroll
        for (int bj = 0; bj < 2; ++bj)
#pragma unroll
            for (int n = 0; n < 2; ++n) { const f32x4 bv = bias ? *(const f32x4*)(bias + col0 + bj * HALF + n * 16) : (f32x4){0.f, 0.f, 0.f, 0.f};
#pragma unroll
                for (int ai = 0; ai < 2; ++ai)
#pragma unroll
                    for (int m = 0; m < 4; ++m) acc[ai][bj][m][n] += bv; }
        f32x4 pre[4][2][2];
#pragma unroll
        for (int m = 0; m < 4; ++m) { const size_t off = (size_t)(u.pm * BM + wr * 64 + m * 16 + fr) * ldc + col0;
#pragma unroll
            for (int bj = 0; bj < 2; ++bj)
#pragma unroll
                for (int n = 0; n < 2; ++n) pre[m][bj][n] = *(const f32x4*)(base + off + bj * HALF + n * 16); }
        const bool bad = st.run(acc, u, wr, wc, fr, fq, lds, wid, lane) || poison != 0u;
        const float qnan = __builtin_nanf("");
#pragma unroll
        for (int ai = 0; ai < 2; ++ai)
#pragma unroll
            for (int m = 0; m < 4; ++m) { const int r = ai * HALF + wr * 64 + m * 16 + fr; const f32x2v sr = S[r]; const size_t off = (size_t)(u.pm * BM + r) * ldc + col0;
#pragma unroll
                for (int bj = 0; bj < 2; ++bj)
#pragma unroll
                    for (int n = 0; n < 2; ++n) { const f32x4 bs = ai == 0 ? pre[m][bj][n] : *(const f32x4*)(base + off + bj * HALF + n * 16); f32x4 o = bs + (acc[ai][bj][m][n] - sr.x) * sr.y;
                        if (bad) o = (f32x4){qnan, qnan, qnan, qnan}; *(f32x4*)(out + off + bj * HALF + n * 16) = o; }
                if (m & 1) asm volatile("" ::: "memory"); }
    }
};
struct EpiLnResLn {
    static constexpr bool PERM = false, AFTER_DRAIN = true;
    const float* base; float* out; bf16_t* xn; int ldc; const float* bias; PanelStats st1, st2; unsigned poison;
    __device__ __forceinline__ void fused(f32x4 (&acc)[2][2][4][2], const Unit& u, int wr, int wc, int fr, int fq, PG8_LAS unsigned char* lds, int wid, int lane) const {
        typedef float f32x2v __attribute__((ext_vector_type(2))); typedef unsigned u32x2v __attribute__((ext_vector_type(2)));
        const PG8_LAS f32x2v* S = (const PG8_LAS f32x2v*)(lds + 8192);
        const int col0 = u.pn * BM + wc * 32 + 4 * fq;
#pragma unroll
        for (int bj = 0; bj < 2; ++bj)
#pragma unroll
            for (int n = 0; n < 2; ++n) { const f32x4 bv = bias ? *(const f32x4*)(bias + col0 + bj * HALF + n * 16) : (f32x4){0.f, 0.f, 0.f, 0.f};
#pragma unroll
                for (int ai = 0; ai < 2; ++ai)
#pragma unroll
                    for (int m = 0; m < 4; ++m) acc[ai][bj][m][n] += bv; }
        bool bad = st1.run(acc, u, wr, wc, fr, fq, lds, wid, lane) || poison != 0u;
        const float qnan = __builtin_nanf("");
#pragma unroll
        for (int ai = 0; ai < 2; ++ai)
#pragma unroll
            for (int m = 0; m < 4; ++m) { const int r = ai * HALF + wr * 64 + m * 16 + fr; const f32x2v sr = S[r]; const size_t off = (size_t)(u.pm * BM + r) * ldc + col0;
#pragma unroll
                for (int bj = 0; bj < 2; ++bj)
#pragma unroll
                    for (int n = 0; n < 2; ++n) { const f32x4 bs = *(const f32x4*)(base + off + bj * HALF + n * 16); acc[ai][bj][m][n] = bs + (acc[ai][bj][m][n] - sr.x) * sr.y; }
                asm volatile("" : "+v"(acc[ai][0][m][0]), "+v"(acc[ai][0][m][1]), "+v"(acc[ai][1][m][0]), "+v"(acc[ai][1][m][1]));
                if (m & 1) asm volatile("" ::: "memory"); }
        const bool bad1 = bad;
        bad = st2.run(acc, u, wr, wc, fr, fq, lds, wid, lane) || bad;
#pragma unroll
        for (int ai = 0; ai < 2; ++ai)
#pragma unroll
            for (int m = 0; m < 4; ++m) { const int r = ai * HALF + wr * 64 + m * 16 + fr; const f32x2v sr = S[r]; const size_t off = (size_t)(u.pm * BM + r) * ldc + col0;
#pragma unroll
                for (int bj = 0; bj < 2; ++bj)
#pragma unroll
                    for (int n = 0; n < 2; ++n) { const f32x4 x1 = acc[ai][bj][m][n]; *(f32x4*)(out + off + bj * HALF + n * 16) = bad1 ? (f32x4){qnan, qnan, qnan, qnan} : x1;
                        const f32x4 o = (x1 - sr.x) * sr.y; u32x2v w; w.x = cvt_pk_bf16(o[0], o[1]); w.y = cvt_pk_bf16(o[2], o[3]);
                        if (bad) { w.x = 0x7fc07fc0u; w.y = 0x7fc07fc0u; } *(u32x2v*)(xn + off + bj * HALF + n * 16) = w; }
                asm volatile("" ::: "memory"); }
    }
};

template <class Epi, class Sched, bool ALIGN_EPI = false, bool SP2 = false>
__device__ __forceinline__ void gemm_phase(PG8_LAS unsigned char* lds, const Gemm g, const Sched& S, const Epi& E) {
    const int tid = threadIdx.x, wid = __builtin_amdgcn_readfirstlane(tid >> 6), lane = tid & 63, wr = wid >> 2, wc = wid & 3, fr = lane & 15, fq = lane >> 4;
    const int K = g.K, nt = K / BK;
    unsigned voffA[2], voffB[2];
#pragma unroll
    for (int i = 0; i < 2; ++i) { int R, C; stage_rc(tid * 16 + i * 8192, R, C); const int Rb = Epi::PERM ? ((R & ~31) + perm32(R & 31)) : R;
        voffA[i] = (unsigned)(R * K + C) * 2u; voffB[i] = (unsigned)(Rb * K + C) * 2u; }
    const size_t kstep = (size_t)(BK * 2);
    const size_t hstep = (size_t)HALF * K * 2;
    const size_t tstep = 2 * hstep;
    const unsigned ldsw = (unsigned)wid * 1024u;
    const int aoff = lds_byte(wr * 64 + fr, fq * 8), boff = lds_byte(wc * 32 + fr, fq * 8);
#define PG8_SA(b, h) (((b) * 2 + (h)) * HTB)
#define PG8_SB(b, h) ((4 + (b) * 2 + (h)) * HTB)
#define PG8_STAGE(bufoff, gbase, voff) do { _Pragma("unroll") for (int _i = 0; _i < 2; ++_i) \
        __builtin_amdgcn_global_load_lds((const unsigned*)((const char*)(gbase) + (voff)[_i]), (PG8_LAS unsigned*)(lds + (bufoff) + ldsw + _i * 8192), 16, 0, 0); } while (0)
#define PG8_LDA(dst, b, h) do { _Pragma("unroll") for (int m = 0; m < 4; ++m) _Pragma("unroll") for (int k = 0; k < 2; ++k) dst[m][k] = *(const PG8_LAS bf16x8*)(lds + PG8_SA(b, h) + aoff + m * 2048 + k * 1024); } while (0)
#define PG8_LDB(dst, b, h) do { _Pragma("unroll") for (int n = 0; n < 2; ++n) _Pragma("unroll") for (int k = 0; k < 2; ++k) dst[n][k] = *(const PG8_LAS bf16x8*)(lds + PG8_SB(b, h) + boff + n * 2048 + k * 1024); } while (0)
#define PG8_MMA(ai, bj, At, Bt) do { __builtin_amdgcn_s_setprio(1); _Pragma("unroll") for (int m = 0; m < 4; ++m) _Pragma("unroll") for (int n = 0; n < 2; ++n) _Pragma("unroll") for (int k = 0; k < 2; ++k) \
        acc[ai][bj][m][n] = __builtin_amdgcn_mfma_f32_16x16x32_bf16(Bt[n][k], At[m][k], acc[ai][bj][m][n], 0, 0, 0); __builtin_amdgcn_s_setprio(0); } while (0)
#define PG8_WAIT_V(n) asm volatile("s_waitcnt vmcnt(" #n ")" ::: "memory")
#define PG8_WAIT_L(n) asm volatile("s_waitcnt lgkmcnt(" #n ")" ::: "memory")
#define PG8_BAR __builtin_amdgcn_s_barrier()
#define PG8_SCHED __builtin_amdgcn_sched_barrier(0)
    Unit cur, nxt; int ui = 0;
    if (!S.next(0, cur)) return;
    f32x4 acc[2][2][4][2];
#pragma unroll
    for (int a = 0; a < 2; ++a)
#pragma unroll
        for (int b = 0; b < 2; ++b)
#pragma unroll
            for (int m = 0; m < 4; ++m)
#pragma unroll
                for (int n = 0; n < 2; ++n) acc[a][b][m][n] = (f32x4){0.f, 0.f, 0.f, 0.f};
    bf16x8 At[4][2], B0[2][2], B1[2][2];
    const char* cA = (const char*)g.A + (size_t)cur.pm * tstep; const char* cB = (const char*)g.Bt + (size_t)cur.pn * tstep;
    S.a_ready(cur);
    if constexpr (SP2) {
        PG8_STAGE(PG8_SB(0, 0), cB, voffB); PG8_STAGE(PG8_SB(0, 1), cB + hstep, voffB); PG8_STAGE(PG8_SA(0, 0), cA, voffA); PG8_STAGE(PG8_SA(0, 1), cA + hstep, voffA);
        if (wr == 1) PG8_BAR;
        PG8_WAIT_V(2); PG8_BAR;
        PG8_STAGE(PG8_SB(1, 0), cB + kstep, voffB); PG8_STAGE(PG8_SA(1, 0), cA + kstep, voffA); PG8_STAGE(PG8_SB(1, 1), cB + hstep + kstep, voffB);
        PG8_WAIT_V(6); PG8_BAR;
    } else {
        PG8_STAGE(PG8_SB(0, 0), cB, voffB); PG8_STAGE(PG8_SA(0, 0), cA, voffA); PG8_STAGE(PG8_SB(0, 1), cB + hstep, voffB); PG8_STAGE(PG8_SA(0, 1), cA + hstep, voffA);
        if (wr == 1) PG8_BAR;
        PG8_WAIT_V(4); PG8_BAR;
        PG8_STAGE(PG8_SB(1, 0), cB + kstep, voffB); PG8_STAGE(PG8_SA(1, 0), cA + kstep, voffA); PG8_STAGE(PG8_SB(1, 1), cB + hstep + kstep, voffB);
        PG8_WAIT_V(6); PG8_BAR;
    }
    for (;;) {
        const bool has_next = S.next(ui + 1, nxt);
        const char* nA = has_next ? (const char*)g.A + (size_t)nxt.pm * tstep : cA; const char* nB = has_next ? (const char*)g.Bt + (size_t)nxt.pn * tstep : cB;
        for (int t = 0; t < nt; t += 2) {
            const bool last = (t == nt - 2);
            const char* a1 = cA + (size_t)(t + 1) * kstep;
            const char* a2 = last ? nA : cA + (size_t)(t + 2) * kstep; const char* b2 = last ? nB : cB + (size_t)(t + 2) * kstep;
            const char* a3 = a2 + kstep; const char* b3 = b2 + kstep;
            if (last && has_next) S.a_ready(nxt);
            if constexpr (SP2) {
            PG8_LDB(B0, 0, 0); PG8_LDB(B1, 0, 1); PG8_SCHED; PG8_LDA(At, 0, 0); PG8_STAGE(PG8_SA(1, 1), a1 + hstep, voffA);
            PG8_WAIT_V(8); PG8_WAIT_L(0); PG8_BAR; PG8_MMA(0, 0, At, B0); PG8_MMA(0, 1, At, B1); PG8_BAR; PG8_SCHED;
            PG8_LDA(At, 0, 1); PG8_STAGE(PG8_SB(0, 0), b2, voffB); PG8_STAGE(PG8_SB(0, 1), b2 + hstep, voffB); PG8_STAGE(PG8_SA(0, 0), a2, voffA);
            PG8_WAIT_V(8); PG8_WAIT_L(0); PG8_BAR; PG8_MMA(1, 0, At, B0); PG8_MMA(1, 1, At, B1); PG8_BAR; PG8_SCHED;
            PG8_LDB(B0, 1, 0); PG8_LDB(B1, 1, 1); PG8_SCHED; PG8_LDA(At, 1, 0); PG8_STAGE(PG8_SA(0, 1), a2 + hstep, voffA);
            PG8_WAIT_V(8); PG8_WAIT_L(0); PG8_BAR; PG8_MMA(0, 0, At, B0); PG8_MMA(0, 1, At, B1); PG8_BAR; PG8_SCHED;
            PG8_LDA(At, 1, 1); PG8_STAGE(PG8_SB(1, 0), b3, voffB); PG8_STAGE(PG8_SB(1, 1), b3 + hstep, voffB); PG8_STAGE(PG8_SA(1, 0), a3, voffA);
            PG8_WAIT_V(8); PG8_WAIT_L(0); PG8_BAR; PG8_MMA(1, 0, At, B0); PG8_MMA(1, 1, At, B1); PG8_BAR; PG8_SCHED;
            } else {
            PG8_LDB(B0, 0, 0); PG8_SCHED; PG8_LDA(At, 0, 0); PG8_STAGE(PG8_SA(1, 1), a1 + hstep, voffA);
            PG8_WAIT_L(8); PG8_BAR; PG8_WAIT_L(0); PG8_MMA(0, 0, At, B0); PG8_BAR; PG8_SCHED;
            PG8_LDB(B1, 0, 1); PG8_STAGE(PG8_SB(0, 0), b2, voffB);
            PG8_BAR; PG8_WAIT_L(0); PG8_MMA(0, 1, At, B1); PG8_BAR;
            PG8_LDA(At, 0, 1); PG8_STAGE(PG8_SA(0, 0), a2, voffA);
            PG8_BAR; PG8_WAIT_L(0); PG8_MMA(1, 0, At, B0); PG8_BAR; PG8_SCHED;
            PG8_STAGE(PG8_SB(0, 1), b2 + hstep, voffB);
            PG8_WAIT_V(6); PG8_BAR; PG8_MMA(1, 1, At, B1); PG8_BAR;
            PG8_LDB(B0, 1, 0); PG8_SCHED; PG8_LDA(At, 1, 0); PG8_STAGE(PG8_SA(0, 1), a2 + hstep, voffA);
            PG8_WAIT_L(8); PG8_BAR; PG8_WAIT_L(0); PG8_MMA(0, 0, At, B0); PG8_BAR; PG8_SCHED;
            PG8_LDB(B1, 1, 1); PG8_STAGE(PG8_SB(1, 0), b3, voffB);
            PG8_BAR; PG8_WAIT_L(0); PG8_MMA(0, 1, At, B1); PG8_BAR;
            PG8_LDA(At, 1, 1); PG8_STAGE(PG8_SA(1, 0), a3, voffA);
            PG8_BAR; PG8_WAIT_L(0); PG8_MMA(1, 0, At, B0); PG8_BAR; PG8_SCHED;
            PG8_STAGE(PG8_SB(1, 1), b3 + hstep, voffB);
            PG8_WAIT_V(6); PG8_BAR; PG8_MMA(1, 1, At, B1); PG8_BAR;
            }
        }
        if constexpr (ALIGN_EPI) { if (wr == 0) PG8_BAR; }
        if constexpr (!Epi::AFTER_DRAIN) { E(acc, cur, wr, wc, fr, fq); S.done(cur); }
        if (!has_next) break;
#pragma unroll
        for (int a = 0; a < 2; ++a)
#pragma unroll
            for (int b = 0; b < 2; ++b)
#pragma unroll
                for (int m = 0; m < 4; ++m)
#pragma unroll
                    for (int n = 0; n < 2; ++n) acc[a][b][m][n] = (f32x4){0.f, 0.f, 0.f, 0.f};
        cur = nxt; cA = nA; cB = nB; ++ui;
        if constexpr (ALIGN_EPI) { if (wr == 1) PG8_BAR; }
    }
    PG8_WAIT_V(0);
    if constexpr (!ALIGN_EPI) { if (wr == 0) PG8_BAR; }
    PG8_BAR;
    if constexpr (Epi::AFTER_DRAIN) { E.fused(acc, cur, wr, wc, fr, fq, lds, wid, lane); S.done(cur); }
#undef PG8_SA
#undef PG8_SB
#undef PG8_STAGE
#undef PG8_LDA
#undef PG8_LDB
#undef PG8_MMA
#undef PG8_WAIT_V
#undef PG8_WAIT_L
#undef PG8_BAR
#undef PG8_SCHED
}
}
#ifndef PG8_SP2
#define PG8_SP2 true
#endif
#ifndef PG8_ALIGN
#define PG8_ALIGN true
#endif
#define GAS __attribute__((address_space(1)))
#define LAS __attribute__((address_space(3)))
typedef unsigned short bf16;
typedef unsigned v4u __attribute__((ext_vector_type(4)));
typedef float f32x4 __attribute__((ext_vector_type(4)));
typedef short bf16x8 __attribute__((ext_vector_type(8)));
typedef GAS unsigned gu32;
typedef GAS unsigned long long gu64;
#define RLX_AGENT __ATOMIC_RELAXED, __HIP_MEMORY_SCOPE_AGENT
#define LDS_WAIT() asm volatile("s_waitcnt lgkmcnt(0)" ::: "memory")
#define VM_WAIT() asm volatile("s_waitcnt vmcnt(0)" ::: "memory")
__device__ __forceinline__ unsigned long long rt() { return __builtin_amdgcn_s_memrealtime(); }
__device__ __forceinline__ unsigned f2bf(float f) { unsigned u = __builtin_bit_cast(unsigned, f); return (u + 0x7fffu + ((u >> 16) & 1u)) >> 16; }
__device__ __forceinline__ unsigned pk2(float lo, float hi) { return f2bf(lo) | (f2bf(hi) << 16); }

#define XB_TMO      128
#define XB_XCNT(j)  (256  + 64 * (j))
#define XB_XSUB(j)  (1280 + 64 * (j))
#define XB_XGEN(j)  (2304 + 64 * (j))
#define XB_TOP      3328
#define XB_TOPGEN   3392
#define XCD_BAR_WORDS 3456
#define XB_SPIN_CAP (1u << 18)

__device__ __forceinline__ unsigned xb_ld(unsigned* p)              { return __hip_atomic_load(p, __ATOMIC_RELAXED, __HIP_MEMORY_SCOPE_AGENT); }
__device__ __forceinline__ unsigned xb_add(unsigned* p, unsigned v) { return __hip_atomic_fetch_add(p, v, __ATOMIC_RELAXED, __HIP_MEMORY_SCOPE_AGENT); }
__device__ __forceinline__ unsigned xb_xcc_id() { return (unsigned)__builtin_amdgcn_s_getreg((3 << 11) | 20) & 0xFu; }
#define XB_SPIN(cond, bar) do { unsigned _sp = 0; while (cond) { __builtin_amdgcn_s_sleep(1); \
    if ((++_sp & 255u) == 0u) { if (xb_ld(&(bar)[XB_TMO])) break; if (_sp > XB_SPIN_CAP) { atomicAdd(&(bar)[XB_TMO], 1u); break; } } } } while (0)

struct XcdBarrier {
    unsigned* bar; unsigned x;
    volatile LAS unsigned* st;
};

__device__ __forceinline__ XcdBarrier xcd_barrier_post(unsigned* bar, volatile LAS unsigned* st) {
    XcdBarrier b; b.bar = bar; b.x = xb_xcc_id(); b.st = st;
    if (threadIdx.x == 0) (void)xb_add(&bar[XB_XCNT(b.x)], 1u);
    return b;
}
__device__ __forceinline__ void xcd_barrier_complete(unsigned* bar, unsigned x, unsigned& nloc, unsigned& nx) {
    const unsigned G = gridDim.x * gridDim.y * gridDim.z;
    unsigned sum, cnt, mine, sp = 0u;
    for (;;) {
        sum = 0u; cnt = 0u; mine = 0u;
#pragma unroll
        for (unsigned j = 0; j < 16; ++j) { const unsigned c = xb_ld(&bar[XB_XCNT(j)]); sum += c; cnt += (c > 0u) ? 1u : 0u; mine = (j == x) ? c : mine; }
        if (sum == G) break;
        __builtin_amdgcn_s_sleep(1);
        if ((++sp & 255u) == 0u) { if (xb_ld(&bar[XB_TMO])) break; if (sp > XB_SPIN_CAP) { atomicAdd(&bar[XB_TMO], 1u); break; } }
    }
    nloc = mine > 0u ? mine : 1u; nx = cnt > 0u ? cnt : 1u;
}

__device__ __forceinline__ void xcd_barrier(const XcdBarrier& b) {
    asm volatile("s_waitcnt vmcnt(0)" ::: "memory");
    __syncthreads();
    if (threadIdx.x == 0) {
        unsigned* bar = b.bar;
        __builtin_amdgcn_s_waitcnt(0);
        unsigned nloc = b.st[0], nx = b.st[1];
        if (nloc == 0u) { xcd_barrier_complete(bar, b.x, nloc, nx); b.st[0] = nloc; b.st[1] = nx; }
        const unsigned old = xb_add(&bar[XB_XSUB(b.x)], 1u);
        const unsigned gen = old / nloc;
        if (old + 1u == (gen + 1u) * nloc) {
            __builtin_amdgcn_fence(__ATOMIC_RELEASE, "agent");
            asm volatile("s_waitcnt vmcnt(0)" ::: "memory");
            const unsigned og = xb_add(&bar[XB_TOP], 1u);
            const unsigned tg = og / nx;
            if (og + 1u == (tg + 1u) * nx) xb_add(&bar[XB_TOPGEN], 1u);
            else XB_SPIN(xb_ld(&bar[XB_TOPGEN]) == tg, bar);
            __builtin_amdgcn_fence(__ATOMIC_ACQUIRE, "agent");
            xb_add(&bar[XB_XGEN(b.x)], 1u);
            asm volatile("s_waitcnt vmcnt(0)" ::: "memory");
        } else {
            XB_SPIN(xb_ld(&bar[XB_XGEN(b.x)]) == gen, bar);
            __builtin_amdgcn_fence(__ATOMIC_ACQUIRE, "agent");
            asm volatile("s_waitcnt vmcnt(0)" ::: "memory");
        }
    }
    __syncthreads();
}
constexpr int NWAVES = 8, NTHREADS = 512;
constexpr int DM = 1024, SEQ = 8192, MP = 16384, NS = 128, MT = 16640;
constexpr int FF = 2816, FF2 = 5632, NMOD = 14336, NIN = 3072, LDW_IN = 3080;
constexpr int QW = 1536;
constexpr float EPSN = 1e-6f;
constexpr float LOG2E = 1.4426950408889634f;
constexpr float ATT_C2 = 0.10206207261596577f * 1.4426950408889634f;
constexpr float QK_SCALE = 0.08838834764831845f;
constexpr size_t O_YP = 0, O_YS = 16777216, O_CP = 16908288, O_NP = 17170432, O_MP = 17171456, O_CONVP = 17171464, O_CKVP = 17193992, O_KPEP = 21388296,
                 O_CS = 21912584, O_NS = 38689800, O_MS = 38755336, O_CONVS = 38755848, O_CKVS = 40197640, O_KPES = 40230408, O_END = 40234504;

constexpr size_t al256(size_t x) { return (x + 255) & ~(size_t)255; }
constexpr size_t WS_CTL = 0, CTL_ZERO_BYTES = 1u << 20;
constexpr size_t WS_WIN   = WS_CTL + CTL_ZERO_BYTES;
constexpr size_t WS_WOUT  = WS_WIN + (size_t)NIN * DM * 2;
constexpr size_t WS_WUP   = WS_WOUT + (size_t)DM * DM * 2;
constexpr size_t WS_WDOWN = WS_WUP + 2 * (size_t)FF2 * DM * 2;
constexpr size_t WS_WDKV  = WS_WDOWN + 2 * (size_t)DM * FF * 2;
constexpr size_t WS_WDQ   = WS_WDKV + (size_t)512 * DM * 2;
constexpr size_t WS_WUQ   = WS_WDQ + (size_t)512 * DM * 2;
constexpr size_t WS_WKV   = WS_WUQ + (size_t)QW * 384 * 2;
constexpr size_t WS_WO    = WS_WKV + (size_t)2048 * 256 * 2;
constexpr size_t WS_WMOD  = WS_WO + (size_t)DM * DM * 2;
constexpr size_t WS_AMOD  = WS_WMOD + (size_t)NMOD * DM * 2;
constexpr size_t WS_MOD   = WS_AMOD + (size_t)256 * DM * 2;
constexpr size_t WS_ROPE  = WS_MOD + (size_t)256 * NMOD * 4;
constexpr size_t WS_X     = al256(WS_ROPE + (size_t)8193 * 32 * 4);
constexpr size_t WS_XN    = WS_X + (size_t)MT * DM * 4;
constexpr size_t WS_XN2   = WS_XN + (size_t)MT * DM * 2;
constexpr size_t WS_QKVO  = WS_XN2 + (size_t)MT * DM * 2;
constexpr size_t WS_GATES = WS_QKVO + (size_t)MT * NIN * 2;
constexpr size_t WS_CT    = al256(WS_GATES + (size_t)MT * 8 * 4);
constexpr size_t WS_NL    = WS_CT + (size_t)8 * 128 * 256 * 128 * 2;
constexpr size_t WS_CHK   = WS_NL + (size_t)8 * 128 * 128 * 4;
constexpr size_t WS_AG    = al256(WS_CHK + 3 * 1024 * 4);
constexpr size_t WS_U     = WS_AG + (size_t)MT * FF2 * 2;
constexpr size_t WS_LAT   = WS_U + (size_t)MT * FF * 2;
constexpr size_t WS_QLAT  = WS_LAT + (size_t)MT * 512 * 4;
constexpr size_t WS_CKV   = WS_QLAT + (size_t)MT * 512 * 4;
constexpr size_t WS_KPE   = WS_CKV + (size_t)MT * 256 * 2;
constexpr size_t WS_QN    = WS_KPE + (size_t)MT * 32 * 2;
constexpr size_t WS_Q     = WS_QN + (size_t)MT * 384 * 2;
constexpr size_t WS_KN    = WS_Q + (size_t)MT * QW * 2;
constexpr size_t WS_V     = WS_KN + (size_t)MT * DM * 2;
constexpr size_t WS_PART  = WS_V + (size_t)MT * DM * 2;
constexpr size_t WS_QLS   = WS_PART + (size_t)256 * (4096 + 32) * 4;
constexpr size_t WS_HALO  = al256(WS_QLS + (size_t)128 * 16 * 288 * 2);
constexpr size_t WS_FIXA  = WS_HALO + (size_t)512 * FF * 2;
constexpr size_t WS_FIXG  = WS_FIXA + (size_t)512 * FF * 2;
constexpr size_t WS_END   = al256(WS_FIXG + (size_t)512 * FF * 2);
constexpr int CW_BAR = 4096;

constexpr int RING_OFF = 0, RING_BYTES = 131072;
constexpr int LDSCTL_OFF = RING_BYTES, MISC_OFF = LDSCTL_OFF + 320;
constexpr int LDS_BYTES = 147456;

struct Params {
    const float *x_p, *x_s, *st_C, *st_n, *st_m, *st_conv, *cache_ckv, *cache_kpe; const int* page_table;
    const float *c_p, *c_s, *g_norm1, *g_norm2, *w_ada, *b_ada, *w_up, *w_conv, *b_conv, *w_down, *w_m_in, *b_m_gates, *g_m_head, *w_m_out,
                *g_kv_in, *w_ada_kv, *b_ada_kv, *w_dkv, *g_kv, *w_uk, *w_uv, *w_dq, *g_q, *w_uq, *w_o, *g_final;
    float* out; unsigned char* ws; int ph_lo, ph_hi, var, pad_;
};

typedef unsigned u32x2 __attribute__((ext_vector_type(2)));
typedef float f32x2 __attribute__((ext_vector_type(2)));
typedef short s16x4 __attribute__((ext_vector_type(4)));
typedef float f32x16 __attribute__((ext_vector_type(16)));
typedef __bf16 bf16x2_t __attribute__((ext_vector_type(2)));

__device__ __forceinline__ unsigned cvtpk(float lo, float hi) { f32x2 v = {lo, hi}; bf16x2_t b = __builtin_convertvector(v, bf16x2_t); return __builtin_bit_cast(unsigned, b); }
__device__ __forceinline__ float bf_lo(unsigned u) { return __uint_as_float(u << 16); }
__device__ __forceinline__ float bf_hi(unsigned u) { return __uint_as_float(u & 0xffff0000u); }
__device__ __forceinline__ float bf2f(bf16 b) { return __uint_as_float((unsigned)b << 16); }
__device__ __forceinline__ float wave_sum(float v) {
#pragma unroll
    for (int o = 1; o < 64; o <<= 1) v += __shfl_xor(v, o);
    return v;
}
__device__ __forceinline__ float wave_max(float v) {
#pragma unroll
    for (int o = 1; o < 64; o <<= 1) v = fmaxf(v, __shfl_xor(v, o));
    return v;
}
__device__ __forceinline__ float wave_scan_add(float v, int lane) {
#pragma unroll
    for (int o = 1; o < 64; o <<= 1) { const float t = __shfl_up(v, o); if (lane >= o) v += t; }
    return v;
}
__device__ __forceinline__ float wave_scan_max(float v, int lane) {
#pragma unroll
    for (int o = 1; o < 64; o <<= 1) { const float t = __shfl_up(v, o); if (lane >= o) v = fmaxf(v, t); }
    return v;
}
__device__ __forceinline__ float sigmoidf_(float x) { return 1.0f / (1.0f + __expf(-x)); }
__device__ __forceinline__ float siluf_(float x) { return x / (1.0f + __expf(-x)); }
__device__ __forceinline__ float log_sigmoidf_(float x) { return x >= 0.f ? -log1pf(__expf(-x)) : x - log1pf(__expf(x)); }
__device__ __forceinline__ int mrow_of(int r) { return r < MP ? 128 + (r >> 13) : (r < MP + NS ? r - MP : 255); }
__device__ __forceinline__ int pos_of(int r) { return r < MP ? (r & (SEQ - 1)) : SEQ; }

struct Ctx {
    LAS unsigned char* lds; int tid, lane, wave, vcu, G, gw, NGW, var;
};

struct EpiMod {
    static constexpr bool PERM = false, AFTER_DRAIN = false;
    float* O; const float* b_ada; const float* b_kv;
    __device__ __forceinline__ void operator()(const pg8::f32x4 (&acc)[2][2][4][2], const pg8::Unit& u, int wr, int wc, int fr, int fq) const {
        const int row0 = u.pm * 256 + wr * 64 + fr, col0 = u.pn * 256 + wc * 32 + 4 * fq;
        const float* bp = (u.pn * 256 < 12288) ? b_ada : (b_kv - 12288);
#pragma unroll
        for (int bj = 0; bj < 2; ++bj)
#pragma unroll
            for (int n = 0; n < 2; ++n) { const int col = col0 + bj * 128 + n * 16; const pg8::f32x4 bv = *(const pg8::f32x4*)(bp + col);
#pragma unroll
                for (int ai = 0; ai < 2; ++ai)
#pragma unroll
                    for (int m = 0; m < 4; ++m) { const int row = row0 + ai * 128 + m * 16; *(pg8::f32x4*)(O + (size_t)row * NMOD + col) = acc[ai][bj][m][n] + bv; } }
    }
};
struct EpiF32 {
    static constexpr bool PERM = false, AFTER_DRAIN = false;
    float* O; int ldc;
    __device__ __forceinline__ void operator()(const pg8::f32x4 (&acc)[2][2][4][2], const pg8::Unit& u, int wr, int wc, int fr, int fq) const {
        const int row0 = u.pm * 256 + wr * 64 + fr, col0 = u.pn * 256 + wc * 32 + 4 * fq;
#pragma unroll
        for (int ai = 0; ai < 2; ++ai)
#pragma unroll
            for (int m = 0; m < 4; ++m) { const int row = row0 + ai * 128 + m * 16;
#pragma unroll
                for (int bj = 0; bj < 2; ++bj)
#pragma unroll
                    for (int n = 0; n < 2; ++n) *(pg8::f32x4*)(O + (size_t)row * ldc + col0 + bj * 128 + n * 16) = acc[ai][bj][m][n]; }
    }
};
struct EpiRes {
    static constexpr bool PERM = false, AFTER_DRAIN = false;
    float* X; const float* gate;
    __device__ __forceinline__ void operator()(const pg8::f32x4 (&acc)[2][2][4][2], const pg8::Unit& u, int wr, int wc, int fr, int fq) const {
        const int row0 = u.pm * 256 + wr * 64 + fr, col0 = u.pn * 256 + wc * 32 + 4 * fq;
#pragma unroll
        for (int ai = 0; ai < 2; ++ai)
#pragma unroll
            for (int m = 0; m < 4; ++m) { const int row = row0 + ai * 128 + m * 16; const float* gp = gate + (size_t)mrow_of(row) * NMOD; float* xp = X + (size_t)row * DM;
#pragma unroll
                for (int bj = 0; bj < 2; ++bj)
#pragma unroll
                    for (int n = 0; n < 2; ++n) { const int col = col0 + bj * 128 + n * 16; const pg8::f32x4 gv = *(const pg8::f32x4*)(gp + col); const pg8::f32x4 xv = *(const pg8::f32x4*)(xp + col);
                        *(pg8::f32x4*)(xp + col) = xv + gv * acc[ai][bj][m][n]; }
                if (m & 1) asm volatile("" ::: "memory"); }
    }
};
struct EpiRope {
    static constexpr bool PERM = false, AFTER_DRAIN = false;
    bf16* Q; const float* tab;
    __device__ __forceinline__ void operator()(const pg8::f32x4 (&acc)[2][2][4][2], const pg8::Unit& u, int wr, int wc, int fr, int fq) const {
        const int row0 = u.pm * 256 + wr * 64 + fr, col0 = u.pn * 256 + wc * 32 + 4 * fq;
#pragma unroll
        for (int ai = 0; ai < 2; ++ai)
#pragma unroll
            for (int m = 0; m < 4; ++m) { const int row = row0 + ai * 128 + m * 16; const int pos = pos_of(row);
#pragma unroll
                for (int bj = 0; bj < 2; ++bj) { const int g = 8 * u.pn + 4 * bj + wc; pg8::f32x4 x1 = acc[ai][bj][m][0], x2 = acc[ai][bj][m][1];
                    if (g % 3 == 2) { const pg8::f32x4 c = *(const pg8::f32x4*)(tab + pos * 16 + 4 * fq), s = *(const pg8::f32x4*)(tab + 8193 * 16 + pos * 16 + 4 * fq);
                        const pg8::f32x4 o1 = x1 * c - x2 * s, o2 = x1 * s + x2 * c; x1 = o1; x2 = o2; }
                    bf16* qp = Q + (size_t)row * QW + col0 + bj * 128;
                    u32x2 w1; w1.x = cvtpk(x1[0], x1[1]); w1.y = cvtpk(x1[2], x1[3]); *(u32x2*)qp = w1;
                    u32x2 w2; w2.x = cvtpk(x2[0], x2[1]); w2.y = cvtpk(x2[2], x2[3]); *(u32x2*)(qp + 16) = w2; }
                asm volatile("" ::: "memory"); }
    }
};
__device__ __forceinline__ void tr_item(const float* W, int ldw, int nblk, int K, bf16* WT, int row_off, float scale, LAS float* scr, int item, int lane) {
    const int kb = item / nblk, nb = item % nblk, k0 = 64 * kb, n0 = 32 * nb;
#pragma unroll 8
    for (int i = 0; i < 32; ++i) { const int kk = 2 * i + (lane >> 5); scr[kk * 33 + (lane & 31)] = W[(size_t)(k0 + kk) * ldw + n0 + (lane & 31)] * scale; }
    LDS_WAIT(); asm volatile("" ::: "memory");
    const int c = lane & 7;
#pragma unroll
    for (int j = 0; j < 4; ++j) { const int n = (lane >> 3) + 8 * j; const LAS float* s = scr + (8 * c) * 33 + n;
        v4u o; o.x = cvtpk(s[0 * 33], s[1 * 33]); o.y = cvtpk(s[2 * 33], s[3 * 33]); o.z = cvtpk(s[4 * 33], s[5 * 33]); o.w = cvtpk(s[6 * 33], s[7 * 33]);
        *(GAS v4u*)(WT + (size_t)(row_off + n0 + n) * K + k0 + 8 * c) = o; }
    LDS_WAIT(); asm volatile("" ::: "memory");
}
template <int GROUP>
__device__ __forceinline__ void tr_items_old(const Params& P, const Ctx& C, int first, int stride) {
    unsigned char* ws = P.ws;
    LAS float* scr = (LAS float*)(C.lds + RING_OFF + C.wave * 16384);
    constexpr int I_IN = 16 * 96, I_OUT = 16 * 32, I_UP = 16 * 176, I_DOWN = 44 * 32, I_DKV = 16 * 9, I_DQ = 16 * 12, I_UQ = 6 * 48, I_UK = 4 * 32, I_O = 16 * 32, I_ADA = 16 * 192, I_ADAKV = 16 * 64;
    constexpr int NB = I_IN + I_OUT + 2 * I_UP + 2 * I_DOWN + I_DKV + I_DQ + I_UQ + 2 * I_UK + I_O, NA = 2 * I_ADA + I_ADAKV;
    for (int it = first; it < (GROUP == 0 ? NA : NB); it += stride) {
        int r = GROUP == 0 ? it + NB : it;
        if (r < I_IN) { const int nb = r % 96; tr_item(P.w_m_in, LDW_IN, 96, DM, (bf16*)(ws + WS_WIN), 0, nb < 16 ? QK_SCALE : 1.f, scr, r, C.lane); continue; } r -= I_IN;
        if (r < I_OUT) { tr_item(P.w_m_out, DM, 32, DM, (bf16*)(ws + WS_WOUT), 0, 1.f, scr, r, C.lane); continue; } r -= I_OUT;
        if (r < 2 * I_UP) { const int l = r / I_UP, rr = r % I_UP, n0 = 32 * (rr % 176), half = n0 >= FF ? 1 : 0, cc = n0 - half * FF;
            tr_item(P.w_up + (size_t)l * DM * FF2, FF2, 176, DM, (bf16*)(ws + WS_WUP) + (size_t)l * FF2 * DM, (cc >> 7) * 256 + half * 128 + (cc & 127) - n0, 1.f, scr, rr, C.lane); continue; } r -= 2 * I_UP;
        if (r < 2 * I_DOWN) { const int l = r / I_DOWN; tr_item(P.w_down + (size_t)l * FF * DM, DM, 32, FF, (bf16*)(ws + WS_WDOWN) + (size_t)l * DM * FF, 0, 1.f, scr, r % I_DOWN, C.lane); continue; } r -= 2 * I_DOWN;
        if (r < I_DKV) { tr_item(P.w_dkv, 288, 9, DM, (bf16*)(ws + WS_WDKV), 0, 1.f, scr, r, C.lane); continue; } r -= I_DKV;
        if (r < I_DQ) { tr_item(P.w_dq, 384, 12, DM, (bf16*)(ws + WS_WDQ), 0, 1.f, scr, r, C.lane); continue; } r -= I_DQ;
        if (r < I_UQ) { tr_item(P.w_uq, QW, 48, 384, (bf16*)(ws + WS_WUQ), 0, ATT_C2, scr, r, C.lane); continue; } r -= I_UQ;
        if (r < I_UK) { tr_item(P.w_uk, DM, 32, 256, (bf16*)(ws + WS_WKV), 0, 1.f, scr, r, C.lane); continue; } r -= I_UK;
        if (r < I_UK) { tr_item(P.w_uv, DM, 32, 256, (bf16*)(ws + WS_WKV), 1024, 1.f, scr, r, C.lane); continue; } r -= I_UK;
        if (r < I_O) { tr_item(P.w_o, DM, 32, DM, (bf16*)(ws + WS_WO), 0, 1.f, scr, r, C.lane); continue; } r -= I_O;
        if (r < 2 * I_ADA) { const int l = r / I_ADA; tr_item(P.w_ada + (size_t)l * DM * 6144, 6144, 192, DM, (bf16*)(ws + WS_WMOD), l * 6144, 1.f, scr, r % I_ADA, C.lane); continue; } r -= 2 * I_ADA;
        tr_item(P.w_ada_kv, 2048, 64, DM, (bf16*)(ws + WS_WMOD), 12288, 1.f, scr, r, C.lane);
    }
}
__device__ __forceinline__ void p0_prologue(const Params& P, const Ctx& C) {
    unsigned char* ws = P.ws;
    tr_items_old<1>(P, C, C.gw, C.NGW);
    tr_items_old<0>(P, C, C.gw, C.NGW);
    const int gt = C.vcu * NTHREADS + C.tid, NGT = C.G * NTHREADS;
    { bf16* am = (bf16*)(ws + WS_AMOD);
      for (int i = gt; i < 256 * DM / 4; i += NGT) { const int row = i / (DM / 4), c4 = (i % (DM / 4)) * 4;
          f32x4 v = {0.f, 0.f, 0.f, 0.f};
          if (row < NS) v = *(const f32x4*)(P.c_s + (size_t)row * DM + c4); else if (row < NS + 2) v = *(const f32x4*)(P.c_p + (size_t)(row - NS) * DM + c4);
          u32x2 w; w.x = cvtpk(siluf_(v[0]), siluf_(v[1])); w.y = cvtpk(siluf_(v[2]), siluf_(v[3])); *(u32x2*)(am + (size_t)row * DM + c4) = w; } }
}
__device__ __forceinline__ void p1_weights(const Params& P, const Ctx& C) {
    unsigned char* ws = P.ws;
    { const int bx = (int)blockIdx.x, nfree = C.G > 56 ? C.G - 56 : 0;
      (void)bx; (void)nfree; }
    const int gt = C.vcu * NTHREADS + C.tid, NGT = C.G * NTHREADS;
    { v4u z = {0u, 0u, 0u, 0u};
      GAS v4u* a = (GAS v4u*)((bf16*)(ws + WS_WDKV) + (size_t)288 * DM); const int na = (512 - 288) * DM / 8;
      for (int i = gt; i < na; i += NGT) a[i] = z;
      GAS v4u* b = (GAS v4u*)((bf16*)(ws + WS_WDQ) + (size_t)384 * DM); const int nb = (512 - 384) * DM / 8;
      for (int i = gt; i < nb; i += NGT) b[i] = z; }
    { float* tab = (float*)(ws + WS_ROPE);
      for (int i = gt; i < 8193 * 16; i += NGT) { const int pos = i >> 4, k = i & 15;
          const double fr = exp2(-(double)k * (13.287712379549449 / 16.0)) * 0.15915494309189535;
          double t = (double)pos * fr; t -= floor(t); const float tf = (float)t;
          tab[i] = __builtin_amdgcn_cosf(tf); tab[8193 * 16 + i] = __builtin_amdgcn_sinf(tf); } }
}

__device__ __forceinline__ void load_row(const float* xr, int lane, f32x4 (&v)[4]) {
#pragma unroll
    for (int j = 0; j < 4; ++j) v[j] = *(const f32x4*)(xr + 4 * lane + 256 * j);
}
__device__ __forceinline__ float row_rstd(const f32x4 (&v)[4]) {
    float s = 0.f;
#pragma unroll
    for (int j = 0; j < 4; ++j) s += (v[j][0] * v[j][0] + v[j][1] * v[j][1]) + (v[j][2] * v[j][2] + v[j][3] * v[j][3]);
    return rsqrtf(wave_sum(s) * (1.f / DM) + EPSN);
}
__device__ __forceinline__ void mod_row(const f32x4 (&v)[4], float rstd, const float* g, const float* sc, const float* sh, int lane, f32x4 (&y)[4]) {
#pragma unroll
    for (int j = 0; j < 4; ++j) { const int c = 4 * lane + 256 * j; const f32x4 gv = *(const f32x4*)(g + c), scv = *(const f32x4*)(sc + c), shv = *(const f32x4*)(sh + c);
        y[j] = (v[j] * rstd) * gv * (scv + 1.0f) + shv; }
}
__device__ __forceinline__ void store_row_bf16(bf16* o, int lane, const f32x4 (&y)[4]) {
#pragma unroll
    for (int j = 0; j < 4; ++j) { u32x2 w; w.x = cvtpk(y[j][0], y[j][1]); w.y = cvtpk(y[j][2], y[j][3]); *(u32x2*)(o + 4 * lane + 256 * j) = w; }
}

__device__ __forceinline__ void p2_norm_in(const Params& P, const Ctx& C) {
    unsigned char* ws = P.ws; const float* MOD = (const float*)(ws + WS_MOD); float* X = (float*)(ws + WS_X); bf16* XN = (bf16*)(ws + WS_XN); float* GT = (float*)(ws + WS_GATES);
    f32x4 wg[4][4][2];
#pragma unroll
    for (int j = 0; j < 4; ++j)
#pragma unroll
        for (int e = 0; e < 4; ++e) { const int k = 4 * C.lane + 256 * j + e; wg[j][e][0] = *(const f32x4*)(P.w_m_in + (size_t)k * LDW_IN + NIN); wg[j][e][1] = *(const f32x4*)(P.w_m_in + (size_t)k * LDW_IN + NIN + 4); }
    for (int r = C.gw; r < MT; r += C.NGW) {
        f32x4 v[4];
        if (r < MP) load_row(P.x_p + (size_t)r * DM, C.lane, v); else if (r < MP + NS) load_row(P.x_s + (size_t)(r - MP) * DM, C.lane, v);
        else { for (int j = 0; j < 4; ++j) v[j] = (f32x4){0.f, 0.f, 0.f, 0.f}; }
#pragma unroll
        for (int j = 0; j < 4; ++j) *(f32x4*)(X + (size_t)r * DM + 4 * C.lane + 256 * j) = v[j];
        const float rstd = row_rstd(v); const float* mr = MOD + (size_t)mrow_of(r) * NMOD;
        f32x4 y[4]; mod_row(v, rstd, P.g_norm1, mr + 1024, mr, C.lane, y);
        store_row_bf16(XN + (size_t)r * DM, C.lane, y);
        f32x4 g0 = {0.f, 0.f, 0.f, 0.f}, g1 = {0.f, 0.f, 0.f, 0.f};
#pragma unroll
        for (int j = 0; j < 4; ++j)
#pragma unroll
            for (int e = 0; e < 4; ++e) { g0 += wg[j][e][0] * y[j][e]; g1 += wg[j][e][1] * y[j][e]; }
#pragma unroll
        for (int q = 0; q < 4; ++q) { g0[q] = wave_sum(g0[q]); g1[q] = wave_sum(g1[q]); }
        if (C.lane == 0) { const f32x4 b0 = *(const f32x4*)(P.b_m_gates), b1 = *(const f32x4*)(P.b_m_gates + 4);
            g0 += b0; g1 += b1; f32x4 lf; lf[0] = log_sigmoidf_(g1[0]); lf[1] = log_sigmoidf_(g1[1]); lf[2] = log_sigmoidf_(g1[2]); lf[3] = log_sigmoidf_(g1[3]);
            *(f32x4*)(GT + (size_t)r * 8) = g0; *(f32x4*)(GT + (size_t)r * 8 + 4) = lf; }
    }
}
__device__ __forceinline__ void norm_rows(const Params& P, const Ctx& C, const float* g, int sc_off, int sh_off, bf16* dst, const float* g2, int sc2_off, int sh2_off, bf16* dst2) {
    unsigned char* ws = P.ws; const float* MOD = (const float*)(ws + WS_MOD); const float* X = (const float*)(ws + WS_X);
    for (int r = C.gw; r < MT; r += C.NGW) {
        f32x4 v[4]; load_row(X + (size_t)r * DM, C.lane, v);
        const float rstd = row_rstd(v); const float* mr = MOD + (size_t)mrow_of(r) * NMOD;
        f32x4 y[4]; mod_row(v, rstd, g, mr + sc_off, mr + sh_off, C.lane, y); store_row_bf16(dst + (size_t)r * DM, C.lane, y);
        if (dst2) { mod_row(v, rstd, g2, mr + sc2_off, mr + sh2_off, C.lane, y); store_row_bf16(dst2 + (size_t)r * DM, C.lane, y); }
    }
}
__device__ __forceinline__ void final_norm(const Params& P, const Ctx& C) {
    const float* X = (const float*)(P.ws + WS_X);
    for (int r = C.gw; r < MP + NS; r += C.NGW) {
        f32x4 v[4]; load_row(X + (size_t)r * DM, C.lane, v); const float rstd = row_rstd(v);
        float* o = P.out + (r < MP ? O_YP + (size_t)r * DM : O_YS + (size_t)(r - MP) * DM);
#pragma unroll
        for (int j = 0; j < 4; ++j) { const int c = 4 * C.lane + 256 * j; *(f32x4*)(o + c) = (v[j] * rstd) * *(const f32x4*)(P.g_final + c); }
    }
}
__device__ __forceinline__ void latent_rows(const Params& P, const Ctx& C) {
    unsigned char* ws = P.ws; const float* LAT = (const float*)(ws + WS_LAT); const float* QLAT = (const float*)(ws + WS_QLAT); const float* tab = (const float*)(ws + WS_ROPE);
    bf16* CKV = (bf16*)(ws + WS_CKV); bf16* KPE = (bf16*)(ws + WS_KPE); bf16* QN = (bf16*)(ws + WS_QN);
    for (int r = C.gw; r < MT; r += C.NGW) {
        const float* lr = LAT + (size_t)r * 512; const int lane = C.lane;
        const f32x4 v = *(const f32x4*)(lr + 4 * lane);
        const float ss = wave_sum((v[0] * v[0] + v[1] * v[1]) + (v[2] * v[2] + v[3] * v[3])); const float rstd = rsqrtf(ss * (1.f / 256.f) + EPSN);
        const f32x4 o = (v * rstd) * *(const f32x4*)(P.g_kv + 4 * lane);
        { u32x2 w; w.x = cvtpk(o[0], o[1]); w.y = cvtpk(o[2], o[3]); *(u32x2*)(CKV + (size_t)r * 256 + 4 * lane) = w; }
        float* ock = nullptr; float* okp = nullptr;
        if (r < MP) { ock = P.out + O_CKVP + (size_t)r * 256; okp = P.out + O_KPEP + (size_t)r * 32; }
        else if (r < MP + NS) { ock = P.out + O_CKVS + (size_t)(r - MP) * 256; okp = P.out + O_KPES + (size_t)(r - MP) * 32; }
        if (ock) *(f32x4*)(ock + 4 * lane) = o;
        { const int pos = pos_of(r); const int i = lane & 15; const float x1 = lr[256 + i], x2 = lr[272 + i]; const float c = tab[pos * 16 + i], s = tab[8193 * 16 + pos * 16 + i];
          const float o1 = x1 * c - x2 * s, o2 = x1 * s + x2 * c;
          if (lane < 16) { KPE[(size_t)r * 32 + i] = (bf16)(cvtpk(o1, 0.f) & 0xffffu); KPE[(size_t)r * 32 + 16 + i] = (bf16)(cvtpk(o2, 0.f) & 0xffffu); if (okp) { okp[i] = o1; okp[16 + i] = o2; } } }
        { const float* qr = QLAT + (size_t)r * 512; f32x2 q[3]; float s = 0.f;
#pragma unroll
          for (int j = 0; j < 3; ++j) { q[j] = *(const f32x2*)(qr + 2 * lane + 128 * j); s += q[j][0] * q[j][0] + q[j][1] * q[j][1]; }
          const float rq = rsqrtf(wave_sum(s) * (1.f / 384.f) + EPSN);
#pragma unroll
          for (int j = 0; j < 3; ++j) { const f32x2 g = *(const f32x2*)(P.g_q + 2 * lane + 128 * j); *(unsigned*)(QN + (size_t)r * 384 + 2 * lane + 128 * j) = cvtpk(q[j][0] * rq * g[0], q[j][1] * rq * g[1]); } }
    }
}
__device__ __forceinline__ void conv_phase(const Params& P, const Ctx& C, int layer) {
    unsigned char* ws = P.ws; const bf16* AG = (const bf16*)(ws + WS_AG); bf16* U = (bf16*)(ws + WS_U);
    const float* wc = P.w_conv + (size_t)layer * 3 * FF; const float* bc = P.b_conv + (size_t)layer * FF;
    const int gt = C.vcu * NTHREADS + C.tid, NGT = C.G * NTHREADS;
    constexpr int NCH = FF / 8, RB = 32, NRB = MP / RB;
    for (int it = gt; it < NRB * NCH; it += NGT) {
        const int rb = it / NCH, ch = it % NCH, c0 = ch * 8, r0 = rb * RB;
        float w0[8], w1[8], w2[8], bb[8];
#pragma unroll
        for (int q = 0; q < 2; ++q) { const f32x4 a = *(const f32x4*)(wc + c0 + 4 * q), b = *(const f32x4*)(wc + FF + c0 + 4 * q), c = *(const f32x4*)(wc + 2 * FF + c0 + 4 * q), d = *(const f32x4*)(bc + c0 + 4 * q);
#pragma unroll
            for (int e = 0; e < 4; ++e) { w0[4 * q + e] = a[e]; w1[4 * q + e] = b[e]; w2[4 * q + e] = c[e]; bb[4 * q + e] = d[e]; } }
        float p2[8], p1[8];
        const bool first = (r0 & (SEQ - 1)) == 0;
        { v4u t2 = {0u, 0u, 0u, 0u}, t1 = {0u, 0u, 0u, 0u};
          if (!first) { t2 = *(const v4u*)(AG + (size_t)(r0 - 2) * FF2 + c0); t1 = *(const v4u*)(AG + (size_t)(r0 - 1) * FF2 + c0); }
#pragma unroll
          for (int e = 0; e < 4; ++e) { p2[2 * e] = bf_lo(t2[e]); p2[2 * e + 1] = bf_hi(t2[e]); p1[2 * e] = bf_lo(t1[e]); p1[2 * e + 1] = bf_hi(t1[e]); } }
#pragma unroll 4
        for (int rr = 0; rr < RB; ++rr) { const int r = r0 + rr;
            const v4u ta = *(const v4u*)(AG + (size_t)r * FF2 + c0), tg = *(const v4u*)(AG + (size_t)r * FF2 + FF + c0);
            float a[8], o[8];
#pragma unroll
            for (int e = 0; e < 4; ++e) { a[2 * e] = bf_lo(ta[e]); a[2 * e + 1] = bf_hi(ta[e]); }
#pragma unroll
            for (int e = 0; e < 8; ++e) { const float cv = bb[e] + w0[e] * p2[e] + w1[e] * p1[e] + w2[e] * a[e]; const float gv = (e & 1) ? bf_hi(tg[e >> 1]) : bf_lo(tg[e >> 1]); o[e] = siluf_(cv) * gv; p2[e] = p1[e]; p1[e] = a[e]; }
            v4u w; w.x = cvtpk(o[0], o[1]); w.y = cvtpk(o[2], o[3]); w.z = cvtpk(o[4], o[5]); w.w = cvtpk(o[6], o[7]);
            *(v4u*)(U + (size_t)r * FF + c0) = w;
            if ((r & (SEQ - 1)) >= SEQ - 2) { float* oc = P.out + O_CONVP + ((size_t)(layer * 2 + (r >> 13)) * 2 + ((r & (SEQ - 1)) - (SEQ - 2))) * FF + c0;
                *(f32x4*)oc = (f32x4){a[0], a[1], a[2], a[3]}; *(f32x4*)(oc + 4) = (f32x4){a[4], a[5], a[6], a[7]}; }
        }
    }
    for (int it = gt; it < 256 * NCH; it += NGT) {
        const int s = it / NCH, ch = it % NCH, c0 = ch * 8, r = MP + s;
        v4u w = {0u, 0u, 0u, 0u};
        if (s < NS) {
            const float* sc = P.st_conv + ((size_t)(layer * NS + s) * 2) * FF + c0;
            const v4u ta = *(const v4u*)(AG + (size_t)r * FF2 + c0), tg = *(const v4u*)(AG + (size_t)r * FF2 + FF + c0);
            float o[8], a[8];
#pragma unroll
            for (int e = 0; e < 4; ++e) { a[2 * e] = bf_lo(ta[e]); a[2 * e + 1] = bf_hi(ta[e]); }
#pragma unroll
            for (int e = 0; e < 8; ++e) { const float cv = bc[c0 + e] + wc[c0 + e] * sc[e] + wc[FF + c0 + e] * sc[FF + e] + wc[2 * FF + c0 + e] * a[e];
                const float gv = (e & 1) ? bf_hi(tg[e >> 1]) : bf_lo(tg[e >> 1]); o[e] = siluf_(cv) * gv; }
            w.x = cvtpk(o[0], o[1]); w.y = cvtpk(o[2], o[3]); w.z = cvtpk(o[4], o[5]); w.w = cvtpk(o[6], o[7]);
            float* oc = P.out + O_CONVS + ((size_t)(layer * NS + s) * 2) * FF + c0;
#pragma unroll
            for (int e = 0; e < 8; ++e) { oc[e] = sc[FF + e]; oc[FF + e] = a[e]; }
        }
        *(v4u*)(U + (size_t)r * FF + c0) = w;
    }
}
typedef short v4i16_t __attribute__((ext_vector_type(4)));
#define MFMA16(a, b, c) __builtin_amdgcn_mfma_f32_16x16x32_bf16((a), (b), (c), 0, 0, 0)
__device__ __forceinline__ s16x4 vtr(LAS const unsigned char* p) { return __builtin_bit_cast(s16x4, __builtin_amdgcn_ds_read_tr16_b64_v4i16((LAS v4i16_t*)p)); }
__device__ __forceinline__ bf16x8 tr_frag(LAS const unsigned char* tile, int stride, int krow0, int c0, int lane) {
    const int g = lane >> 4, q = (lane >> 2) & 3, p = lane & 3;
    LAS const unsigned char* a = tile + (krow0 + 8 * g + q) * stride + (c0 + 4 * p) * 2;
    const s16x4 lo = vtr(a), hi = vtr(a + 4 * stride);
    return (bf16x8){lo[0], lo[1], lo[2], lo[3], hi[0], hi[1], hi[2], hi[3]};
}
constexpr int KS_STRIDE = 272, VS_STRIDE = 528, PS_STRIDE = 144;

__device__ __forceinline__ void m1_unit(const Params& P, const Ctx& C, int bh, int c) {
    unsigned char* ws = P.ws; const bf16* QKVO = (const bf16*)(ws + WS_QKVO); const float* GT = (const float*)(ws + WS_GATES);
    bf16* CT = (bf16*)(ws + WS_CT); float* NL = (float*)(ws + WS_NL); float* CHK = (float*)(ws + WS_CHK);
    const int b = bh >> 2, h = bh & 3, r0 = b * SEQ + c * 64, lane = C.lane, tid = C.tid, wave = C.wave;
    LAS unsigned char* Ks = C.lds; LAS unsigned char* Vs = C.lds + 64 * KS_STRIDE;
    const float lf = GT[(size_t)(r0 + lane) * 8 + 4 + h], li = GT[(size_t)(r0 + lane) * 8 + h];
    const float bcum = wave_scan_add(lf, lane); const float g = __shfl(bcum, 63);
    const float a = g - bcum + li; const float mloc = wave_max(a); const float wa = __expf(a - mloc);
    if (tid == 0) { CHK[bh * 128 + c] = g; CHK[1024 + bh * 128 + c] = mloc; }
#pragma unroll
    for (int i = 0; i < 2; ++i) { const int j = (tid >> 4) + 32 * i, ch = tid & 15;
        const v4u kv = *(const v4u*)(QKVO + (size_t)(r0 + j) * NIN + 512 + h * 128 + ch * 8); const float w = __shfl(wa, j);
        v4u o;
#pragma unroll
        for (int e = 0; e < 4; ++e) o[e] = cvtpk(bf_lo(kv[e]) * w, bf_hi(kv[e]) * w);
        *(LAS v4u*)(Ks + j * KS_STRIDE + ch * 16) = o; }
#pragma unroll
    for (int i = 0; i < 4; ++i) { const int j = (tid >> 5) + 16 * i, ch = tid & 31;
        *(LAS v4u*)(Vs + j * VS_STRIDE + ch * 16) = *(const v4u*)(QKVO + (size_t)(r0 + j) * NIN + 1024 + h * 256 + ch * 8); }
    __syncthreads();
    if (tid < 128) { float s = 0.f;
#pragma unroll 8
        for (int j = 0; j < 64; ++j) s += bf2f(*(LAS const bf16*)(Ks + j * KS_STRIDE + tid * 2));
        NL[(size_t)(bh * 128 + c) * 128 + tid] = s; }
    f32x4 acc[8][2];
#pragma unroll
    for (int dt = 0; dt < 8; ++dt) { acc[dt][0] = (f32x4){0.f, 0.f, 0.f, 0.f}; acc[dt][1] = (f32x4){0.f, 0.f, 0.f, 0.f}; }
#pragma unroll
    for (int ks = 0; ks < 2; ++ks) {
        const bf16x8 bv0 = tr_frag(Vs, VS_STRIDE, 32 * ks, 32 * wave, lane), bv1 = tr_frag(Vs, VS_STRIDE, 32 * ks, 32 * wave + 16, lane);
#pragma unroll
        for (int dt = 0; dt < 8; ++dt) { const bf16x8 ak = tr_frag(Ks, KS_STRIDE, 32 * ks, 16 * dt, lane);
            acc[dt][0] = MFMA16(ak, bv0, acc[dt][0]); acc[dt][1] = MFMA16(ak, bv1, acc[dt][1]); }
    }
#pragma unroll
    for (int dt = 0; dt < 8; ++dt)
#pragma unroll
        for (int et = 0; et < 2; ++et) { const int e = 32 * wave + 16 * et + (lane & 15), d0 = 16 * dt + 4 * (lane >> 4);
            u32x2 w; w.x = cvtpk(acc[dt][et][0], acc[dt][et][1]); w.y = cvtpk(acc[dt][et][2], acc[dt][et][3]);
            *(u32x2*)(CT + ((size_t)(bh * 128 + c) * 256 + e) * 128 + d0) = w; }
    __syncthreads();
}

__device__ __forceinline__ void mstep_unit(const Params& P, const Ctx& C, int s, int h) {
    unsigned char* ws = P.ws; const bf16* QKVO = (const bf16*)(ws + WS_QKVO); const float* GT = (const float*)(ws + WS_GATES); bf16* HH = (bf16*)(ws + WS_XN);
    const int r = MP + s, tid = C.tid, lane = C.lane, wave = C.wave;
    LAS float* qs = (LAS float*)C.lds; LAS float* red = qs + 512; LAS float* misc = qs + 512 + 2048;
    { const bf16* src = QKVO + (size_t)r * NIN; float val;
      if (tid < 128) val = bf2f(src[h * 128 + tid]); else if (tid < 256) val = bf2f(src[512 + h * 128 + (tid - 128)]); else val = bf2f(src[1024 + h * 256 + (tid - 256)]);
      qs[tid] = val; }
    const float li = GT[(size_t)r * 8 + h], lf = GT[(size_t)r * 8 + 4 + h], m_st = P.st_m[s * 4 + h];
    const float m_new = fmaxf(lf + m_st, li), fw = __expf(lf + m_st - m_new), iw = __expf(li - m_new);
    __syncthreads();
    const int e4 = (tid & 63) * 4;
    f32x4 num = {0.f, 0.f, 0.f, 0.f}; const f32x4 vv = *(LAS const f32x4*)(qs + 256 + e4);
    const size_t cbase = (size_t)(s * 4 + h) * 128 * 256;
#pragma unroll
    for (int dd = 0; dd < 16; ++dd) { const int d = 16 * wave + dd; const f32x4 c4 = *(const f32x4*)(P.st_C + cbase + (size_t)d * 256 + e4); const float kd = qs[128 + d], qd = qs[d];
        const f32x4 cn = c4 * fw + vv * (iw * kd); *(f32x4*)(P.out + O_CS + cbase + (size_t)d * 256 + e4) = cn; num += cn * qd; }
    *(LAS f32x4*)(red + wave * 256 + e4) = num;
    float dpart = 0.f;
    if (tid < 128) { const float nn = fw * P.st_n[(size_t)(s * 4 + h) * 128 + tid] + iw * qs[128 + tid]; P.out[O_NS + (size_t)(s * 4 + h) * 128 + tid] = nn; dpart = qs[tid] * nn; }
    dpart = wave_sum(dpart); if (lane == 0) misc[wave] = dpart;
    __syncthreads();
    const float den = misc[0] + misc[1]; const float inv = 1.0f / fmaxf(fabsf(den), __expf(-m_new));
    float hv = 0.f;
    if (tid < 256) { float sum = 0.f;
#pragma unroll
        for (int w = 0; w < 8; ++w) sum += red[w * 256 + tid];
        hv = sum * inv; }
    const float ss = wave_sum(hv * hv); if (lane == 0) misc[8 + wave] = ss;
    __syncthreads();
    float tot = 0.f;
#pragma unroll
    for (int w = 0; w < 8; ++w) tot += misc[8 + w];
    const float rstd = rsqrtf(tot * (1.f / 256.f) + EPSN);
    if (tid < 256) { const float og = bf2f(QKVO[(size_t)r * NIN + 2048 + h * 256 + tid]); const float o = hv * rstd * P.g_m_head[h * 256 + tid] * sigmoidf_(og);
        HH[(size_t)r * DM + h * 256 + tid] = (bf16)(cvtpk(o, 0.f) & 0xffffu); }
    if (tid == 0) P.out[O_MS + s * 4 + h] = m_new;
    __syncthreads();
}

__device__ __forceinline__ void m2_scan(const Params& P, const Ctx& C) {
    unsigned char* ws = P.ws; unsigned* CT32 = (unsigned*)(ws + WS_CT); float* NL = (float*)(ws + WS_NL); float* CHK = (float*)(ws + WS_CHK);
    const int gt = C.vcu * NTHREADS + C.tid, NGT = C.G * NTHREADS;
    for (int idx = gt; idx < 8 * 16384; idx += NGT) {
        const int bh = idx >> 14, p = idx & 16383, e = p >> 6, d = (p & 63) * 2;
        unsigned* ct = CT32 + (((size_t)bh * 128 * 256 + e) * 128 + d) / 2;
        const bool do_n = p < 128; float* nl = NL + (size_t)bh * 128 * 128 + (do_n ? p : 0);
        float c0 = 0.f, c1 = 0.f, m = 0.f, nst = 0.f;
        for (int cb = 0; cb < 128; cb += 8) {
            unsigned cur[8]; float nv[8];
#pragma unroll
            for (int k = 0; k < 8; ++k) { cur[k] = ct[(size_t)(cb + k) * 16384]; nv[k] = do_n ? nl[(cb + k) * 128] : 0.f; }
#pragma unroll
            for (int k = 0; k < 8; ++k) { const int c = cb + k; const float g = CHK[bh * 128 + c], ml = CHK[1024 + bh * 128 + c];
                const float m_new = fmaxf(g + m, ml), fw = __expf(g + m - m_new), lw = __expf(ml - m_new);
                ct[(size_t)c * 16384] = cvtpk(c0, c1); c0 = fw * c0 + lw * bf_lo(cur[k]); c1 = fw * c1 + lw * bf_hi(cur[k]);
                if (do_n) { nl[c * 128] = nst; nst = fw * nst + lw * nv[k]; }
                if (p == 0) CHK[2048 + bh * 128 + c] = m;
                m = m_new; }
        }
        P.out[O_CP + ((size_t)bh * 128 + d) * 256 + e] = c0; P.out[O_CP + ((size_t)bh * 128 + d + 1) * 256 + e] = c1;
        if (do_n) P.out[O_NP + bh * 128 + p] = nst;
        if (p == 0) P.out[O_MP + bh] = m;
    }
}

__device__ __forceinline__ void m3_unit(const Params& P, const Ctx& C, int bh, int c) {
    unsigned char* ws = P.ws; const bf16* QKVO = (const bf16*)(ws + WS_QKVO); const float* GT = (const float*)(ws + WS_GATES);
    const bf16* CT = (const bf16*)(ws + WS_CT); const float* NL = (const float*)(ws + WS_NL); const float* CHK = (const float*)(ws + WS_CHK); bf16* HH = (bf16*)(ws + WS_XN);
    const int b = bh >> 2, h = bh & 3, r0 = b * SEQ + c * 64, lane = C.lane, tid = C.tid, wave = C.wave, g = lane >> 4, l15 = lane & 15;
    LAS unsigned char* Qs = C.lds; LAS unsigned char* Ks = C.lds + 17408; LAS unsigned char* Vs = C.lds + 34816; LAS unsigned char* Ps = C.lds + 68608;
    LAS float* sb = (LAS float*)(C.lds + 77824); LAS float* su = sb + 64; LAS float* sms = sb + 128; LAS float* swi = sb + 192; LAS float* sqn = sb + 256; LAS float* dsum = sb + 320; LAS float* ssq = sb + 576;
    { const float lf = GT[(size_t)(r0 + lane) * 8 + 4 + h], li = GT[(size_t)(r0 + lane) * 8 + h];
      const float bcum = wave_scan_add(lf, lane); const float u = li - bcum; const float pm = wave_scan_max(u, lane); const float mprev = CHK[2048 + bh * 128 + c];
      const float w0 = bcum + mprev, ms = fmaxf(w0, bcum + pm), wi = __expf(w0 - ms);
      if (wave == 0) { sb[lane] = bcum - ms; su[lane] = u; sms[lane] = ms; swi[lane] = wi; } }
    bf16x8 bC[2][4];
#pragma unroll
    for (int et = 0; et < 2; ++et)
#pragma unroll
        for (int ks = 0; ks < 4; ++ks) bC[et][ks] = *(const bf16x8*)(CT + ((size_t)(bh * 128 + c) * 256 + 32 * wave + 16 * et + l15) * 128 + 32 * ks + 8 * g);
#pragma unroll
    for (int i = 0; i < 2; ++i) { const int j = (tid >> 4) + 32 * i, ch = tid & 15; const bf16* src = QKVO + (size_t)(r0 + j) * NIN + h * 128 + ch * 8;
        *(LAS v4u*)(Qs + j * KS_STRIDE + ch * 16) = *(const v4u*)src; *(LAS v4u*)(Ks + j * KS_STRIDE + ch * 16) = *(const v4u*)(src + 512); }
#pragma unroll
    for (int i = 0; i < 4; ++i) { const int j = (tid >> 5) + 16 * i, ch = tid & 31;
        *(LAS v4u*)(Vs + j * VS_STRIDE + ch * 16) = *(const v4u*)(QKVO + (size_t)(r0 + j) * NIN + 1024 + h * 256 + ch * 8); }
    __syncthreads();
    { const int i = 8 * wave + (lane >> 3), d0 = (lane & 7) * 16; float s = 0.f; const float* np = NL + (size_t)(bh * 128 + c) * 128 + d0;
#pragma unroll
      for (int dd = 0; dd < 16; ++dd) s += bf2f(*(LAS const bf16*)(Qs + i * KS_STRIDE + (d0 + dd) * 2)) * np[dd];
      s += __shfl_xor(s, 1); s += __shfl_xor(s, 2); s += __shfl_xor(s, 4); if ((lane & 7) == 0) sqn[i] = s; }
    { const int jt = wave >> 1;
#pragma unroll
      for (int tt = 0; tt < 2; ++tt) { const int it = 2 * (wave & 1) + tt, i = 16 * it + l15;
          u32x2 pw = {0u, 0u}; float psum = 0.f;
          if (jt <= it) { f32x4 sacc = {0.f, 0.f, 0.f, 0.f};
#pragma unroll
              for (int ks = 0; ks < 4; ++ks) { const bf16x8 a = *(LAS const bf16x8*)(Ks + (16 * jt + l15) * KS_STRIDE + (32 * ks + 8 * g) * 2), bq = *(LAS const bf16x8*)(Qs + (16 * it + l15) * KS_STRIDE + (32 * ks + 8 * g) * 2);
                  sacc = MFMA16(a, bq, sacc); }
              const float bim = sb[i]; float pv[4];
#pragma unroll
              for (int ii = 0; ii < 4; ++ii) { const int j = 16 * jt + 4 * g + ii; pv[ii] = (j <= i) ? sacc[ii] * __expf(bim + su[j]) : 0.f; psum += pv[ii]; }
              pw.x = cvtpk(pv[0], pv[1]); pw.y = cvtpk(pv[2], pv[3]); }
          *(LAS u32x2*)(Ps + i * PS_STRIDE + (16 * jt + 4 * g) * 2) = pw;
          psum += __shfl_xor(psum, 16); psum += __shfl_xor(psum, 32); if (g == 0) dsum[jt * 64 + i] = psum; } }
    __syncthreads();
    f32x4 ai[4][2], ax[4][2];
#pragma unroll
    for (int it = 0; it < 4; ++it)
#pragma unroll
        for (int et = 0; et < 2; ++et) { ai[it][et] = (f32x4){0.f, 0.f, 0.f, 0.f}; ax[it][et] = (f32x4){0.f, 0.f, 0.f, 0.f}; }
#pragma unroll
    for (int ks = 0; ks < 4; ++ks)
#pragma unroll
        for (int it = 0; it < 4; ++it) { const bf16x8 aq = *(LAS const bf16x8*)(Qs + (16 * it + l15) * KS_STRIDE + (32 * ks + 8 * g) * 2);
            ai[it][0] = MFMA16(aq, bC[0][ks], ai[it][0]); ai[it][1] = MFMA16(aq, bC[1][ks], ai[it][1]); }
#pragma unroll
    for (int ks = 0; ks < 2; ++ks) { const bf16x8 bv0 = tr_frag(Vs, VS_STRIDE, 32 * ks, 32 * wave, lane), bv1 = tr_frag(Vs, VS_STRIDE, 32 * ks, 32 * wave + 16, lane);
#pragma unroll
        for (int it = 0; it < 4; ++it) { const bf16x8 ap = *(LAS const bf16x8*)(Ps + (16 * it + l15) * PS_STRIDE + (32 * ks + 8 * g) * 2);
            ax[it][0] = MFMA16(ap, bv0, ax[it][0]); ax[it][1] = MFMA16(ap, bv1, ax[it][1]); } }
#pragma unroll
    for (int it = 0; it < 4; ++it)
#pragma unroll
        for (int ii = 0; ii < 4; ++ii) { const int i = 16 * it + 4 * g + ii; const float wi = swi[i];
            const float den = wi * sqn[i] + (dsum[i] + dsum[64 + i]) + (dsum[128 + i] + dsum[192 + i]); const float inv = 1.0f / fmaxf(fabsf(den), __expf(-sms[i]));
            const float h0 = (wi * ai[it][0][ii] + ax[it][0][ii]) * inv, h1 = (wi * ai[it][1][ii] + ax[it][1][ii]) * inv; ai[it][0][ii] = h0; ai[it][1][ii] = h1;
            float ss = h0 * h0 + h1 * h1; ss += __shfl_xor(ss, 1); ss += __shfl_xor(ss, 2); ss += __shfl_xor(ss, 4); ss += __shfl_xor(ss, 8);
            if (l15 == 0) ssq[wave * 64 + i] = ss; }
    __syncthreads();
#pragma unroll
    for (int it = 0; it < 4; ++it)
#pragma unroll
        for (int ii = 0; ii < 4; ++ii) { const int i = 16 * it + 4 * g + ii; float tot = 0.f;
#pragma unroll
            for (int w = 0; w < 8; ++w) tot += ssq[w * 64 + i];
            const float rstd = rsqrtf(tot * (1.f / 256.f) + EPSN);
#pragma unroll
            for (int et = 0; et < 2; ++et) { const int e = 32 * wave + 16 * et + l15; const float og = bf2f(QKVO[(size_t)(r0 + i) * NIN + 2048 + h * 256 + e]);
                const float o = ai[it][et][ii] * rstd * P.g_m_head[h * 256 + e] * sigmoidf_(og); HH[(size_t)(r0 + i) * DM + h * 256 + e] = (bf16)(cvtpk(o, 0.f) & 0xffffu); } }
    __syncthreads();
}
namespace att {
constexpr int QB = 256, KVBLK = 64, NSLOT = 3, KSLOT = 12288, VSLOT = 8192;
constexpr int LDS_K = 0, LDS_V = NSLOT * KSLOT, LDS_WS = LDS_V + NSLOT * VSLOT, LDS_OST = LDS_WS + 8 * 256, LDS_BYTES = LDS_OST + 8 * 4096;
#define MFMA32(a, b, c) __builtin_amdgcn_mfma_f32_32x32x16_bf16((a), (b), (c), 0, 0, 0)
__device__ __forceinline__ int crow(int r, int hi) { return (r & 3) + 8 * (r >> 2) + 4 * hi; }
__device__ __forceinline__ void glds16(const void* gsrc, unsigned lds_dst) { unsigned keep;
    asm volatile("s_mov_b32 %0, m0\n\ts_mov_b32 m0, %2\n\ts_nop 0\n\tglobal_load_lds_dwordx4 %1, off\n\ts_mov_b32 m0, %0" : "=&s"(keep) : "v"(gsrc), "s"(lds_dst) : "memory"); }
#define MX3(a, b, c) __builtin_fmaxf(__builtin_fmaxf((a), (b)), (c))
__device__ __forceinline__ float rowmax(const f32x16& p0, const f32x16& p1) {
    float a = MX3(p0[0], p0[1], p1[0]), b = MX3(p0[2], p0[3], p1[1]); a = MX3(a, p1[2], p1[3]);
#pragma unroll
    for (int r = 4; r < 16; r += 4) { a = MX3(a, p0[r], p0[r + 1]); b = MX3(b, p0[r + 2], p0[r + 3]); a = MX3(a, p1[r], p1[r + 1]); b = MX3(b, p1[r + 2], p1[r + 3]); }
    float m = __builtin_fmaxf(a, b); auto rr = __builtin_amdgcn_permlane32_swap(__float_as_uint(m), __float_as_uint(m), false, false);
    return __builtin_fmaxf(__uint_as_float(rr[0]), __uint_as_float(rr[1])); }
__device__ __forceinline__ void cmask(f32x16& p0, f32x16& p1, int jb, int qrel, int hi) {
    const int kb = 64 * jb + 4 * hi;
#pragma unroll
    for (int r = 0; r < 16; ++r) { const int kv = kb + (r & 3) + 8 * (r >> 2); if (kv > qrel) p0[r] = -INFINITY; if (kv + 32 > qrel) p1[r] = -INFINITY; } }

__device__ __forceinline__ void attn_unit(int b, int h, int qb, const bf16* Q, const bf16* __restrict__ KN, const bf16* __restrict__ KPE, const bf16* __restrict__ V, bf16* O, const float* __restrict__ tab, LAS unsigned char* shm) {
    const int tid = threadIdx.x, lane = tid & 63, r32 = lane & 31, hi = lane >> 5; const int wid = __builtin_amdgcn_readfirstlane(tid >> 6);
    const long rowbase = (long)b * SEQ; const int q0 = qb * QB, NT = (q0 + QB) / KVBLK;
    const bf16* Qw = Q + (rowbase + q0 + wid * 32) * QW + h * 96;
    const unsigned lds0 = (unsigned)(uintptr_t)shm; LAS float* wsf = (LAS float*)(shm + LDS_WS) + wid * 64;
    const bf16* ksrc = KN + (rowbase + lane) * DM + h * 64 + wid * 8;
    const bf16* psrc = KPE + (rowbase + lane) * 32 + (wid & 3) * 8;
    const bf16* vsrc = V + (rowbase + 16 * (wid & 3) + (lane >> 2)) * DM + h * 64 + (wid >> 2) * 32 + (lane & 3) * 8;
    const unsigned kdst = lds0 + LDS_K + wid * 1024, pdst = lds0 + LDS_K + (8 + (wid & 3)) * 1024, vdst = lds0 + LDS_V + wid * 1024;
#define DMA_T(t, sl) do { glds16(ksrc + (long)(t) * KVBLK * DM, (unsigned)__builtin_amdgcn_readfirstlane(kdst + (sl) * KSLOT)); \
                          glds16(psrc + (long)(t) * KVBLK * 32, (unsigned)__builtin_amdgcn_readfirstlane(pdst + (sl) * KSLOT)); \
                          glds16(vsrc + (long)(t) * KVBLK * DM, (unsigned)__builtin_amdgcn_readfirstlane(vdst + (sl) * VSLOT)); } while (0)
    bf16x8 qr[6];
#pragma unroll
    for (int d0 = 0; d0 < 6; ++d0) qr[d0] = *reinterpret_cast<const bf16x8*>(&Qw[(long)r32 * QW + d0 * 16 + hi * 8]);
    {
      const int pos = q0 + wid * 32 + r32; const float* cp = tab + pos * 16 + 8 * hi; const float* sp = cp + 8193 * 16;
      const f32x4 c0 = *(const f32x4*)cp, c1 = *(const f32x4*)(cp + 4), s0 = *(const f32x4*)sp, s1 = *(const f32x4*)(sp + 4);
      const v4u a = __builtin_bit_cast(v4u, qr[4]), bq = __builtin_bit_cast(v4u, qr[5]); v4u oa, ob;
#pragma unroll
      for (int e = 0; e < 4; ++e) { const float cl = e < 2 ? c0[2 * e] : c1[2 * e - 4], ch = e < 2 ? c0[2 * e + 1] : c1[2 * e - 3], sl_ = e < 2 ? s0[2 * e] : s1[2 * e - 4], sh = e < 2 ? s0[2 * e + 1] : s1[2 * e - 3];
          const float x1l = bf_lo(a[e]), x1h = bf_hi(a[e]), x2l = bf_lo(bq[e]), x2h = bf_hi(bq[e]);
          oa[e] = cvtpk(x1l * cl - x2l * sl_, x1h * ch - x2h * sh); ob[e] = cvtpk(x1l * sl_ + x2l * cl, x1h * sh + x2h * ch); }
      qr[4] = __builtin_bit_cast(bf16x8, oa); qr[5] = __builtin_bit_cast(bf16x8, ob); }
    DMA_T(0, 0); DMA_T(1, 1);
    float m_run = -1e30f, l_reg = 0.f; f32x16 o[2]; o[0] = f32x16{}; o[1] = f32x16{};
    const int qrel = wid * 32 + r32;
    const LAS unsigned char* shm3 = shm;
    int sl = 0;
    for (int t = 0; t < NT; ++t) {
        if (t + 1 < NT) asm volatile("s_waitcnt vmcnt(3) lgkmcnt(0)\n\ts_barrier" ::: "memory"); else asm volatile("s_waitcnt vmcnt(0) lgkmcnt(0)\n\ts_barrier" ::: "memory");
        if (t + 2 < NT) { const int s2 = (sl == 0) ? 2 : sl - 1; DMA_T(t + 2, s2); }
        f32x16 p0 = f32x16{}, p1 = f32x16{};
        { const LAS unsigned char* kb = shm3 + LDS_K + sl * KSLOT + hi * 1024 + r32 * 16;
#pragma unroll
          for (int d0 = 0; d0 < 6; ++d0) { const bf16x8 b0 = *(const LAS bf16x8*)(kb + d0 * 2048), b1 = *(const LAS bf16x8*)(kb + d0 * 2048 + 512);
              p0 = MFMA32(b0, qr[d0], p0); p1 = MFMA32(b1, qr[d0], p1); } }
        if (t >= NT - 4) cmask(p0, p1, t - (NT - 4), qrel, hi);
        const float rm = rowmax(p0, p1); const float m_new = fmaxf(m_run, rm); const float alpha = __builtin_amdgcn_exp2f(m_run - m_new); m_run = m_new;
        float sacc = 0.f;
#pragma unroll
        for (int r = 0; r < 16; ++r) { p0[r] = __builtin_amdgcn_exp2f(p0[r] - m_new); p1[r] = __builtin_amdgcn_exp2f(p1[r] - m_new); sacc += p0[r] + p1[r]; }
        l_reg = l_reg * alpha + sacc;
        if (__any(alpha != 1.0f)) { if (hi == 0) wsf[r32] = alpha; asm volatile("s_waitcnt lgkmcnt(0)" ::: "memory");
#pragma unroll
            for (int d_ = 0; d_ < 2; ++d_)
#pragma unroll
                for (int r = 0; r < 16; ++r) o[d_][r] *= wsf[crow(r, hi)];
            asm volatile("s_waitcnt lgkmcnt(0)" ::: "memory"); }
        bf16x8 pa[4];
#pragma unroll
        for (int k = 0; k < 2; ++k) { v4u w0, w1;
#pragma unroll
            for (int e = 0; e < 4; ++e) { w0[e] = cvtpk(p0[8 * k + 2 * e], p0[8 * k + 2 * e + 1]); w1[e] = cvtpk(p1[8 * k + 2 * e], p1[8 * k + 2 * e + 1]); }
            pa[k] = __builtin_bit_cast(bf16x8, w0); pa[2 + k] = __builtin_bit_cast(bf16x8, w1); }
        { const LAS unsigned char* vb = shm3 + LDS_V + sl * VSLOT + ((lane >> 4) & 1) * 32 + (lane & 3) * 8 + (4 * hi + ((lane & 15) >> 2)) * 64;
#pragma unroll
          for (int d0 = 0; d0 < 2; ++d0)
#pragma unroll
              for (int ks = 0; ks < 4; ++ks) { const s16x4 lo = vtr(vb + d0 * 4096 + ks * 1024), hh = vtr(vb + d0 * 4096 + ks * 1024 + 512);
                  const bf16x8 vf = (bf16x8){lo[0], lo[1], lo[2], lo[3], hh[0], hh[1], hh[2], hh[3]};
                  o[d0] = MFMA32(pa[ks], vf, o[d0]); } }
        sl = (sl == 2) ? 0 : sl + 1;
    }
    { auto rr = __builtin_amdgcn_permlane32_swap(__float_as_uint(l_reg), __float_as_uint(l_reg), false, false); l_reg = __uint_as_float(rr[0]) + __uint_as_float(rr[1]); }
    if (hi == 0) wsf[32 + r32] = l_reg; asm volatile("s_waitcnt lgkmcnt(0)" ::: "memory");
    float rli[16];
#pragma unroll
    for (int r = 0; r < 16; ++r) rli[r] = __builtin_amdgcn_rcpf(wsf[32 + crow(r, hi)]);
    bf16* Ow = O + (rowbase + q0 + wid * 32) * DM + h * 64;
    { LAS bf16* stg = (LAS bf16*)(shm + LDS_OST) + wid * 2048;
#pragma unroll
      for (int r = 0; r < 16; ++r) { const int orow = crow(r, hi);
#pragma unroll
          for (int d0 = 0; d0 < 2; ++d0) stg[orow * 64 + d0 * 32 + r32] = (bf16)(cvtpk(o[d0][r] * rli[r], 0.f) & 0xffffu); }
      asm volatile("s_waitcnt lgkmcnt(0)" ::: "memory");
#pragma unroll
      for (int i = 0; i < 4; ++i) { const int row = i * 8 + (lane >> 3), ch = lane & 7; const v4u v = *(const LAS v4u*)(stg + row * 64 + ch * 8); *(v4u*)(Ow + (long)row * DM + ch * 8) = v; } }
    asm volatile("s_waitcnt vmcnt(0) lgkmcnt(0)\n\ts_barrier" ::: "memory");
#undef DMA_T
}
}
namespace dec {
constexpr int TS = 592, TILE_BYTES = 64 * TS;
constexpr int L_T0 = 0, L_QS = 2 * TILE_BYTES, L_QF = L_QS + 16 * TS, L_END = L_QF + QW * 4;
constexpr int PART_STRIDE = 4096 + 32;

__device__ __forceinline__ void decode_unit(const Params& P, const Ctx& C, int s, int half) {
    unsigned char* ws = P.ws; const bf16* Q = (const bf16*)(ws + WS_Q); const bf16* WKV = (const bf16*)(ws + WS_WKV); float* PART = (float*)(ws + WS_PART); bf16* QLS = (bf16*)(ws + WS_QLS);
    const int r = MP + s, tid = C.tid, lane = C.lane, wave = C.wave, g = lane >> 4, l15 = lane & 15;
    LAS unsigned char* Qs = C.lds + L_QS; LAS float* qf = (LAS float*)(C.lds + L_QF);
    for (int i = tid; i < QW; i += NTHREADS) qf[i] = bf2f(Q[(size_t)r * QW + i]);
    __syncthreads();
    { const int c = tid & 255, hh = tid >> 8;
#pragma unroll 1
      for (int h8 = 0; h8 < 8; ++h8) { const int h = 8 * hh + h8; float acc = 0.f; const bf16* wp = WKV + (size_t)(h * 64) * 256 + c;
#pragma unroll 16
          for (int d = 0; d < 64; ++d) acc += qf[h * 96 + d] * bf2f(wp[(size_t)d * 256]);
          *(LAS bf16*)(Qs + h * TS + c * 2) = (bf16)(cvtpk(acc, 0.f) & 0xffffu); }
      { const int h = tid >> 5, rr = tid & 31, i = rr & 15; const float* tab = (const float*)(ws + WS_ROPE) + SEQ * 16;
        const float x1 = qf[h * 96 + 64 + i], x2 = qf[h * 96 + 80 + i], cc = tab[i], sn = tab[8193 * 16 + i];
        const float o = rr < 16 ? x1 * cc - x2 * sn : x1 * sn + x2 * cc;
        *(LAS bf16*)(Qs + h * TS + (256 + rr) * 2) = (bf16)(cvtpk(o, 0.f) & 0xffffu); } }
    __syncthreads();
    bf16x8 qfr[9];
#pragma unroll
    for (int ks = 0; ks < 9; ++ks) qfr[ks] = *(LAS const bf16x8*)(Qs + l15 * TS + (32 * ks + 8 * g) * 2);
    if (half == 0) { for (int i = tid; i < 16 * 288; i += NTHREADS) { const int h = i / 288, c = i % 288; QLS[(size_t)s * 16 * 288 + i] = *(LAS const bf16*)(Qs + h * TS + c * 2); } }
    const int* pt = P.page_table + s * 64 + 32 * half;
    f32x4 ld[8], ldp;
#define DEC_LOAD(tt) do { const int phys_ = pt[(tt) >> 1]; const size_t krow_ = (size_t)phys_ * 128 + ((tt) & 1) * 64; \
        _Pragma("unroll") for (int i_ = 0; i_ < 8; ++i_) { const int e_ = tid + 512 * i_; ld[i_] = *(const f32x4*)(P.cache_ckv + (krow_ + (e_ >> 6)) * 256 + (e_ & 63) * 4); } \
        ldp = *(const f32x4*)(P.cache_kpe + (krow_ + (tid >> 3)) * 32 + (tid & 7) * 4); } while (0)
#define DEC_STORE(buf) do { LAS unsigned char* b_ = C.lds + (buf) * TILE_BYTES; \
        _Pragma("unroll") for (int i_ = 0; i_ < 8; ++i_) { const int e_ = tid + 512 * i_; u32x2 w_; w_.x = cvtpk(ld[i_][0], ld[i_][1]); w_.y = cvtpk(ld[i_][2], ld[i_][3]); *(LAS u32x2*)(b_ + (e_ >> 6) * TS + (e_ & 63) * 8) = w_; } \
        { u32x2 w_; w_.x = cvtpk(ldp[0], ldp[1]); w_.y = cvtpk(ldp[2], ldp[3]); *(LAS u32x2*)(b_ + (tid >> 3) * TS + 512 + (tid & 7) * 8) = w_; } } while (0)
    float m_run = -1e30f, l_run = 0.f; f32x4 oacc[2]; oacc[0] = (f32x4){0.f, 0.f, 0.f, 0.f}; oacc[1] = (f32x4){0.f, 0.f, 0.f, 0.f};
    DEC_LOAD(0); DEC_STORE(0);
    __syncthreads();
    for (int tt = 0; tt < 64; ++tt) {
        if (tt + 1 < 64) DEC_LOAD(tt + 1);
        const LAS unsigned char* buf = C.lds + (tt & 1) * TILE_BYTES;
        f32x4 sT[4];
#pragma unroll
        for (int kt = 0; kt < 4; ++kt) { sT[kt] = (f32x4){0.f, 0.f, 0.f, 0.f};
#pragma unroll
            for (int ks = 0; ks < 9; ++ks) { const bf16x8 a = *(const LAS bf16x8*)(buf + (16 * kt + l15) * TS + (32 * ks + 8 * g) * 2); sT[kt] = MFMA16(a, qfr[ks], sT[kt]); } }
        float mx = fmaxf(fmaxf(sT[0][0], sT[0][1]), fmaxf(sT[0][2], sT[0][3]));
#pragma unroll
        for (int kt = 1; kt < 4; ++kt) mx = fmaxf(mx, fmaxf(fmaxf(sT[kt][0], sT[kt][1]), fmaxf(sT[kt][2], sT[kt][3])));
        mx = fmaxf(mx, __shfl_xor(mx, 16)); mx = fmaxf(mx, __shfl_xor(mx, 32));
        const float m_new = fmaxf(m_run, mx), alpha = __builtin_amdgcn_exp2f(m_run - m_new); m_run = m_new;
        float sum = 0.f;
#pragma unroll
        for (int kt = 0; kt < 4; ++kt)
#pragma unroll
            for (int i = 0; i < 4; ++i) { const float p = __builtin_amdgcn_exp2f(sT[kt][i] - m_new); sT[kt][i] = p; sum += p; }
        sum += __shfl_xor(sum, 16); sum += __shfl_xor(sum, 32);
        l_run = l_run * alpha + sum;
#pragma unroll
        for (int i = 0; i < 4; ++i) { const float ai = __shfl(alpha, 4 * g + i); oacc[0][i] *= ai; oacc[1][i] *= ai; }
#pragma unroll
        for (int kk = 0; kk < 2; ++kk) { v4u pw; pw.x = cvtpk(sT[2 * kk][0], sT[2 * kk][1]); pw.y = cvtpk(sT[2 * kk][2], sT[2 * kk][3]); pw.z = cvtpk(sT[2 * kk + 1][0], sT[2 * kk + 1][1]); pw.w = cvtpk(sT[2 * kk + 1][2], sT[2 * kk + 1][3]);
            const bf16x8 pa = __builtin_bit_cast(bf16x8, pw);
#pragma unroll
            for (int nt = 0; nt < 2; ++nt) { const int c0 = 32 * wave + 16 * nt; const LAS unsigned char* a0 = buf + (32 * kk + 4 * g + ((lane >> 2) & 3)) * TS + (c0 + 4 * (lane & 3)) * 2;
                const s16x4 lo = vtr(a0), hi = vtr(a0 + 16 * TS);
                const bf16x8 bfr = (bf16x8){lo[0], lo[1], lo[2], lo[3], hi[0], hi[1], hi[2], hi[3]};
                oacc[nt] = MFMA16(pa, bfr, oacc[nt]); } }
        if (tt + 1 < 64) DEC_STORE((tt + 1) & 1);
        __syncthreads();
    }
    float* pp = PART + (size_t)(s * 2 + half) * PART_STRIDE;
#pragma unroll
    for (int nt = 0; nt < 2; ++nt)
#pragma unroll
        for (int i = 0; i < 4; ++i) pp[(4 * g + i) * 256 + 32 * wave + 16 * nt + l15] = oacc[nt][i];
    if (wave == 0 && g == 0) { pp[4096 + l15] = m_run; pp[4112 + l15] = l_run; }
#undef DEC_LOAD
#undef DEC_STORE
}

__device__ __forceinline__ void combine_unit(const Params& P, const Ctx& C, int s) {
    unsigned char* ws = P.ws; const bf16* WKV = (const bf16*)(ws + WS_WKV); const float* PART = (const float*)(ws + WS_PART); const bf16* QLS = (const bf16*)(ws + WS_QLS);
    const bf16* CKV = (const bf16*)(ws + WS_CKV); const bf16* KPE = (const bf16*)(ws + WS_KPE); bf16* ATT = (bf16*)(ws + WS_XN);
    const int r = MP + s, tid = C.tid; LAS float* olat = (LAS float*)C.lds;
    { const int h = tid >> 5, l32 = tid & 31; const bf16* ql = QLS + ((size_t)s * 16 + h) * 288; float sn = 0.f;
#pragma unroll
      for (int k = 0; k < 9; ++k) { const int c = l32 + 32 * k; const float kv = c < 256 ? bf2f(CKV[(size_t)r * 256 + c]) : bf2f(KPE[(size_t)r * 32 + c - 256]); sn += bf2f(ql[c]) * kv; }
      sn += __shfl_xor(sn, 1); sn += __shfl_xor(sn, 2); sn += __shfl_xor(sn, 4); sn += __shfl_xor(sn, 8); sn += __shfl_xor(sn, 16);
      const float* p0 = PART + (size_t)(2 * s) * PART_STRIDE; const float* p1 = p0 + PART_STRIDE;
      const float m0 = p0[4096 + h], l0 = p0[4112 + h], m1 = p1[4096 + h], l1 = p1[4112 + h];
      const float m = fmaxf(fmaxf(m0, m1), sn), w0 = __builtin_amdgcn_exp2f(m0 - m), w1 = __builtin_amdgcn_exp2f(m1 - m), wn = __builtin_amdgcn_exp2f(sn - m);
      const float inv = 1.0f / (w0 * l0 + w1 * l1 + wn);
#pragma unroll
      for (int k = 0; k < 8; ++k) { const int c = l32 + 32 * k; olat[h * 256 + c] = (w0 * p0[h * 256 + c] + w1 * p1[h * 256 + c] + wn * bf2f(CKV[(size_t)r * 256 + c])) * inv; } }
    __syncthreads();
#pragma unroll
    for (int q = 0; q < 2; ++q) { const int n = 2 * tid + q, h = n >> 6; const bf16* wp = WKV + (size_t)(1024 + n) * 256; float acc = 0.f;
#pragma unroll 4
        for (int k = 0; k < 32; ++k) { const v4u w = *(const v4u*)(wp + 8 * k); const f32x4 a = *(LAS const f32x4*)(olat + h * 256 + 8 * k), b = *(LAS const f32x4*)(olat + h * 256 + 8 * k + 4);
            acc += a[0] * bf_lo(w[0]) + a[1] * bf_hi(w[0]) + a[2] * bf_lo(w[1]) + a[3] * bf_hi(w[1]) + b[0] * bf_lo(w[2]) + b[1] * bf_hi(w[2]) + b[2] * bf_lo(w[3]) + b[3] * bf_hi(w[3]); }
        ATT[(size_t)r * DM + n] = (bf16)(cvtpk(acc, 0.f) & 0xffffu); }
    __syncthreads();
}
}
template <int NT, class Epi>
__device__ __forceinline__ void sgemm_units(const Ctx& C, const bf16* A, int lda, const bf16* Bt, int K, int nunits, const Epi& E) {
    if (C.var & 1) return;
    const int g = C.lane >> 4, l15 = C.lane & 15, kq = C.wave & 3, mh = C.wave >> 2, KQ = K >> 2;
    const bf16* ap = A + (size_t)(64 * mh + l15) * lda + kq * KQ + 8 * g;
    LAS f32x4* red = (LAS f32x4*)(C.lds + RING_OFF);
    for (int u = C.G - 1 - (int)blockIdx.x; u < nunits; u += C.G) {
        f32x4 acc[4][NT]; const bf16* bp[NT];
#pragma unroll
        for (int nt = 0; nt < NT; ++nt) { bp[nt] = Bt + (size_t)(E.brow(u, nt) + l15) * K + kq * KQ + 8 * g;
#pragma unroll
            for (int mt = 0; mt < 4; ++mt) acc[mt][nt] = (f32x4){0.f, 0.f, 0.f, 0.f}; }
#pragma unroll 4
        for (int ks = 0; ks < KQ / 32; ++ks) { bf16x8 b[NT], a[4];
#pragma unroll
            for (int nt = 0; nt < NT; ++nt) b[nt] = *(const bf16x8*)(bp[nt] + 32 * ks);
#pragma unroll
            for (int mt = 0; mt < 4; ++mt) a[mt] = *(const bf16x8*)(ap + (size_t)(16 * mt) * lda + 32 * ks);
#pragma unroll
            for (int mt = 0; mt < 4; ++mt)
#pragma unroll
                for (int nt = 0; nt < NT; ++nt) acc[mt][nt] = MFMA16(b[nt], a[mt], acc[mt][nt]); }
#pragma unroll
        for (int mt = 0; mt < 4; ++mt)
#pragma unroll
            for (int nt = 0; nt < NT; ++nt) red[((C.wave * 4 + mt) * NT + nt) * 64 + C.lane] = acc[mt][nt];
        __syncthreads();
        f32x4 fin[NT];
#pragma unroll
        for (int nt = 0; nt < NT; ++nt) { f32x4 s = red[(((mh * 4 + 0) * 4 + kq) * NT + nt) * 64 + C.lane];
#pragma unroll
            for (int q = 1; q < 4; ++q) s += red[(((mh * 4 + q) * 4 + kq) * NT + nt) * 64 + C.lane];
            fin[nt] = s; }
        E(u, 64 * mh + 16 * kq + l15, 4 * g, fin);
        __syncthreads();
    }
}
struct SEpiBf16 {
    bf16* O; int ldc;
    __device__ __forceinline__ int brow(int u, int nt) const { return 32 * u + 16 * nt; }
    __device__ __forceinline__ void operator()(int u, int row, int c4, const f32x4 (&acc)[2]) const {
#pragma unroll
        for (int nt = 0; nt < 2; ++nt) { u32x2 w; w.x = cvtpk(acc[nt][0], acc[nt][1]); w.y = cvtpk(acc[nt][2], acc[nt][3]); *(u32x2*)(O + (size_t)(MP + row) * ldc + 32 * u + 16 * nt + c4) = w; }
    }
};
struct SEpiF32 {
    float* O; int ldc;
    __device__ __forceinline__ int brow(int u, int nt) const { return 32 * u + 16 * nt; }
    __device__ __forceinline__ void operator()(int u, int row, int c4, const f32x4 (&acc)[2]) const {
#pragma unroll
        for (int nt = 0; nt < 2; ++nt) *(f32x4*)(O + (size_t)(MP + row) * ldc + 32 * u + 16 * nt + c4) = acc[nt];
    }
};
struct SEpiRes {
    float* X; const float* gate;
    __device__ __forceinline__ int brow(int u, int nt) const { return 16 * u; }
    __device__ __forceinline__ void operator()(int u, int row, int c4, const f32x4 (&acc)[1]) const {
        float* xp = X + (size_t)(MP + row) * DM + 16 * u + c4; const f32x4 gv = *(const f32x4*)(gate + (size_t)row * NMOD + 16 * u + c4);
        *(f32x4*)xp = *(const f32x4*)xp + gv * acc[0];
    }
};
struct SEpiUpConv {
    bf16* U; const float* wc; const float* bc; const float* st; float* oc;
    __device__ __forceinline__ int brow(int u, int nt) const { return (u >> 3) * 256 + (u & 7) * 16 + nt * 128; }
    __device__ __forceinline__ void operator()(int u, int row, int c4, const f32x4 (&acc)[2]) const {
        const int c = 16 * u + c4; const float* sp = st + (size_t)row * 2 * FF + c; float* op = oc + (size_t)row * 2 * FF + c;
        const f32x4 s0 = *(const f32x4*)sp, s1 = *(const f32x4*)(sp + FF), w0 = *(const f32x4*)(wc + c), w1 = *(const f32x4*)(wc + FF + c), w2 = *(const f32x4*)(wc + 2 * FF + c), bb = *(const f32x4*)(bc + c);
        const f32x4 cv = bb + w0 * s0 + w1 * s1 + w2 * acc[0];
        f32x4 o;
#pragma unroll
        for (int e = 0; e < 4; ++e) o[e] = siluf_(cv[e]) * acc[1][e];
        u32x2 w; w.x = cvtpk(o[0], o[1]); w.y = cvtpk(o[2], o[3]); *(u32x2*)(U + (size_t)(MP + row) * FF + c) = w;
        *(f32x4*)op = s1; *(f32x4*)(op + FF) = acc[0];
    }
};

struct EpiUpConv {
    static constexpr bool PERM = true, AFTER_DRAIN = false;
    bf16* U; bf16* HALO; bf16* FIXA; bf16* FIXG; const float* wc; const float* bc;
    __device__ __forceinline__ void operator()(const pg8::f32x4 (&acc)[2][2][4][2], const pg8::Unit& u, int wr, int wcv, int fr, int fq) const {
        const int cc = u.pn * 128 + wcv * 32 + 8 * fq, lane = fq * 16 + fr;
        float w0[8], w1[8], w2[8], bb[8];
#pragma unroll
        for (int q = 0; q < 2; ++q) { const f32x4 a = *(const f32x4*)(wc + cc + 4 * q), b = *(const f32x4*)(wc + FF + cc + 4 * q), c = *(const f32x4*)(wc + 2 * FF + cc + 4 * q), d = *(const f32x4*)(bc + cc + 4 * q);
#pragma unroll
            for (int e = 0; e < 4; ++e) { w0[4 * q + e] = a[e]; w1[4 * q + e] = b[e]; w2[4 * q + e] = c[e]; bb[4 * q + e] = d[e]; } }
        const int src1 = (lane & 48) | ((fr + 15) & 15), src2 = (lane & 48) | ((fr + 14) & 15);
#pragma unroll
        for (int ai = 0; ai < 2; ++ai) {
            float q1[8], q2[8];
#pragma unroll
            for (int e = 0; e < 8; ++e) { q1[e] = 0.f; q2[e] = 0.f; }
#pragma unroll
            for (int m = 0; m < 4; ++m) {
                const int row = u.pm * 256 + ai * 128 + wr * 64 + m * 16 + fr, blk = row >> 6;
                float a[8], gt[8], o[8];
#pragma unroll
                for (int e = 0; e < 8; ++e) { a[e] = acc[ai][0][m][e >> 2][e & 3]; gt[e] = acc[ai][1][m][e >> 2][e & 3]; }
#pragma unroll
                for (int e = 0; e < 8; ++e) { const float r1 = __shfl(a[e], src1), r2 = __shfl(a[e], src2);
                    const float x1 = fr >= 1 ? r1 : q1[e], x2 = fr >= 2 ? r2 : q2[e]; q1[e] = r1; q2[e] = r2;
                    const float cv = bb[e] + w0[e] * x2 + w1[e] * x1 + w2[e] * a[e]; o[e] = siluf_(cv) * gt[e]; }
                pg8::u32x4 wa; wa.x = cvtpk(a[0], a[1]); wa.y = cvtpk(a[2], a[3]); wa.z = cvtpk(a[4], a[5]); wa.w = cvtpk(a[6], a[7]);
                if (m == 0 && fr < 2) { pg8::u32x4 wg; wg.x = cvtpk(gt[0], gt[1]); wg.y = cvtpk(gt[2], gt[3]); wg.z = cvtpk(gt[4], gt[5]); wg.w = cvtpk(gt[6], gt[7]);
                    *(pg8::u32x4*)(FIXA + (size_t)(blk * 2 + fr) * FF + cc) = wa; *(pg8::u32x4*)(FIXG + (size_t)(blk * 2 + fr) * FF + cc) = wg; }
                else { pg8::u32x4 wo; wo.x = cvtpk(o[0], o[1]); wo.y = cvtpk(o[2], o[3]); wo.z = cvtpk(o[4], o[5]); wo.w = cvtpk(o[6], o[7]); *(pg8::u32x4*)(U + (size_t)row * FF + cc) = wo; }
                if (m == 3 && fr >= 14) *(pg8::u32x4*)(HALO + (size_t)(blk * 2 + fr - 14) * FF + cc) = wa;
            }
        }
    }
};
__device__ __forceinline__ void conv_fixup(const Params& P, const Ctx& C, int layer) {
    unsigned char* ws = P.ws; bf16* U = (bf16*)(ws + WS_U); const bf16* HALO = (const bf16*)(ws + WS_HALO); const bf16* FIXA = (const bf16*)(ws + WS_FIXA); const bf16* FIXG = (const bf16*)(ws + WS_FIXG);
    const float* wc = P.w_conv + (size_t)layer * 3 * FF; const float* bc = P.b_conv + (size_t)layer * FF;
    const int gt_ = C.vcu * NTHREADS + C.tid, NGT = C.G * NTHREADS; constexpr int NCH = FF / 8;
    for (int it = gt_; it < 512 * NCH; it += NGT) {
        const int rj = it / NCH, ch = it % NCH, c0 = ch * 8, blk = rj >> 1, j = rj & 1, row = blk * 64 + j; const bool first = (blk & 127) == 0;
        const v4u ta = *(const v4u*)(FIXA + (size_t)rj * FF + c0), tg = *(const v4u*)(FIXG + (size_t)rj * FF + c0);
        v4u t1 = {0u, 0u, 0u, 0u}, t2 = {0u, 0u, 0u, 0u};
        if (j == 1) { t1 = *(const v4u*)(FIXA + (size_t)(rj - 1) * FF + c0); if (!first) t2 = *(const v4u*)(HALO + (size_t)((blk - 1) * 2 + 1) * FF + c0); }
        else if (!first) { t1 = *(const v4u*)(HALO + (size_t)((blk - 1) * 2 + 1) * FF + c0); t2 = *(const v4u*)(HALO + (size_t)((blk - 1) * 2) * FF + c0); }
        float o[8];
#pragma unroll
        for (int e = 0; e < 8; ++e) { const int q = e >> 1; const float a = (e & 1) ? bf_hi(ta[q]) : bf_lo(ta[q]), g = (e & 1) ? bf_hi(tg[q]) : bf_lo(tg[q]), x1 = (e & 1) ? bf_hi(t1[q]) : bf_lo(t1[q]), x2 = (e & 1) ? bf_hi(t2[q]) : bf_lo(t2[q]);
            const float cv = bc[c0 + e] + wc[c0 + e] * x2 + wc[FF + c0 + e] * x1 + wc[2 * FF + c0 + e] * a; o[e] = siluf_(cv) * g; }
        v4u w; w.x = cvtpk(o[0], o[1]); w.y = cvtpk(o[2], o[3]); w.z = cvtpk(o[4], o[5]); w.w = cvtpk(o[6], o[7]);
        *(v4u*)(U + (size_t)row * FF + c0) = w;
    }
    for (int it = gt_; it < 4 * NCH; it += NGT) {
        const int bj = it / NCH, ch = it % NCH, c0 = ch * 8, b = bj >> 1, j = bj & 1;
        const v4u t = *(const v4u*)(HALO + (size_t)((128 * b + 127) * 2 + j) * FF + c0); float* oc = P.out + O_CONVP + ((size_t)(layer * 2 + b) * 2 + j) * FF + c0;
        *(f32x4*)oc = (f32x4){bf_lo(t[0]), bf_hi(t[0]), bf_lo(t[1]), bf_hi(t[1])}; *(f32x4*)(oc + 4) = (f32x4){bf_lo(t[2]), bf_hi(t[2]), bf_lo(t[3]), bf_hi(t[3])};
    }
}
#ifndef MK_ONE_LAUNCH
#define MK_ONE_LAUNCH 1
#endif
constexpr int N_PHASES = 25;
__global__ void __launch_bounds__(NTHREADS, 2) mk_fwd(Params P) {
    extern __shared__ __attribute__((aligned(16))) unsigned char lds_raw[];
    Ctx C;
    C.lds = (LAS unsigned char*)lds_raw;
    C.tid = threadIdx.x; C.lane = C.tid & 63; C.wave = __builtin_amdgcn_readfirstlane(C.tid >> 6);
    C.G = gridDim.x; { const int bx = blockIdx.x; C.vcu = (C.G % 8 == 0) ? (bx % 8) * (C.G / 8) + bx / 8 : bx; }
    C.gw = C.vcu * NWAVES + C.wave; C.NGW = C.G * NWAVES; C.var = P.var;
    unsigned char* ws = P.ws;
    volatile LAS unsigned* MISC = (volatile LAS unsigned*)(C.lds + MISC_OFF);
    for (int u = C.tid; u < (LDS_BYTES - LDSCTL_OFF) / 4; u += NTHREADS) ((LAS unsigned*)(C.lds + LDSCTL_OFF))[u] = 0u;
    __syncthreads();
    XcdBarrier bar; bar.bar = (unsigned*)(ws + WS_CTL) + CW_BAR; bar.x = 0; bar.st = nullptr;
    if (MK_ONE_LAUNCH) bar = xcd_barrier_post((unsigned*)(ws + WS_CTL) + CW_BAR, MISC + 8);
    const int lo = P.ph_lo, hi = P.ph_hi;
#ifdef ONLY_PHASE
#define IN(k) (((k) == ONLY_PHASE) && lo <= (k) && (k) < hi)
#else
#define IN(k) (lo <= (k) && (k) < hi)
#endif
#ifndef PROBE_MASK
#define PROBE_MASK 0u
#endif
#define REP(k)
#define SEAM(k) do { if (MK_ONE_LAUNCH && IN(k) && IN((k) + 1)) xcd_barrier(bar); } while (0)
    LAS unsigned char* ring = C.lds + RING_OFF;
    const float* MOD = (const float*)(ws + WS_MOD); float* X = (float*)(ws + WS_X);
    bf16* XN = (bf16*)(ws + WS_XN); bf16* XN2 = (bf16*)(ws + WS_XN2);

    if (IN(0)) REP(0) { p0_prologue(P, C); } SEAM(0);
    if (IN(1)) REP(1) { pg8::Gemm g{(const bf16*)(ws + WS_AMOD), (const bf16*)(ws + WS_WMOD), 256, NMOD, DM}; pg8::StaticOrder S; S.init(256, NMOD, C.G, (int)blockIdx.x);
        EpiMod E{(float*)(ws + WS_MOD), P.b_ada, P.b_ada_kv};
        pg8::gemm_phase<EpiMod, pg8::StaticOrder, false, true>(ring, g, S, E);
        __syncthreads(); p1_weights(P, C); } SEAM(1);
    if (IN(2)) REP(2) { p2_norm_in(P, C); } SEAM(2);
    if (IN(3)) REP(3) { pg8::Gemm g{XN, (const bf16*)(ws + WS_WIN), MP, NIN, DM}; pg8::StaticOrder S; S.init(MP, NIN, C.G, (int)blockIdx.x);
        pg8::EpiBf16<0> E{(bf16*)(ws + WS_QKVO), NIN, nullptr, 0, 0, 1.f};
        pg8::gemm_phase<pg8::EpiBf16<0>, pg8::StaticOrder, true, true>(ring, g, S, E);
        SEpiBf16 SE{(bf16*)(ws + WS_QKVO), NIN}; sgemm_units<2>(C, XN + (size_t)MP * DM, DM, (const bf16*)(ws + WS_WIN), DM, NIN / 32, SE); } SEAM(3);
    if (IN(4)) REP(4) { for (int u = C.vcu; u < 1024 + 512; u += C.G) { if (u < 1024) m1_unit(P, C, u >> 7, u & 127); else mstep_unit(P, C, (u - 1024) >> 2, (u - 1024) & 3); } } SEAM(4);
    if (IN(5)) REP(5) { m2_scan(P, C); } SEAM(5);
    if (IN(6)) REP(6) { for (int u = C.vcu; u < 1024; u += C.G) m3_unit(P, C, u >> 7, u & 127); } SEAM(6);
    if (IN(7)) REP(7) { pg8::Gemm g{XN, (const bf16*)(ws + WS_WOUT), MP, DM, DM}; pg8::StaticOrder S; S.init(MP, DM, C.G, (int)blockIdx.x);
        EpiRes E{X, MOD + 2048};
        pg8::gemm_phase<EpiRes, pg8::StaticOrder, true, true>(ring, g, S, E);
        SEpiRes SE{X, MOD + 2048}; sgemm_units<1>(C, XN + (size_t)MP * DM, DM, (const bf16*)(ws + WS_WOUT), DM, DM / 16, SE); } SEAM(7);
    if (IN(8)) REP(8) { norm_rows(P, C, P.g_norm2, 4096, 3072, XN, nullptr, 0, 0, nullptr); } SEAM(8);
    if (IN(9)) REP(9) { pg8::Gemm g{XN, (const bf16*)(ws + WS_WUP), MP, FF2, DM}; pg8::StaticOrder S; S.init(MP, FF2, C.G, (int)blockIdx.x);
        EpiUpConv E{(bf16*)(ws + WS_U), (bf16*)(ws + WS_HALO), (bf16*)(ws + WS_FIXA), (bf16*)(ws + WS_FIXG), P.w_conv + (size_t)0 * 3 * FF, P.b_conv + (size_t)0 * FF};
        pg8::gemm_phase<EpiUpConv, pg8::StaticOrder, true, true>(ring, g, S, E);
        SEpiUpConv SE{(bf16*)(ws + WS_U), P.w_conv + (size_t)0 * 3 * FF, P.b_conv + (size_t)0 * FF, P.st_conv + (size_t)0 * NS * 2 * FF, P.out + O_CONVS + (size_t)0 * NS * 2 * FF};
        sgemm_units<2>(C, XN + (size_t)MP * DM, DM, (const bf16*)(ws + WS_WUP), DM, FF / 16, SE); } SEAM(9);
    if (IN(10)) REP(10) { conv_fixup(P, C, 0); } SEAM(10);
    if (IN(11)) REP(11) { pg8::Gemm g{(const bf16*)(ws + WS_U), (const bf16*)(ws + WS_WDOWN), MP, DM, FF}; pg8::StaticOrder S; S.init(MP, DM, C.G, (int)blockIdx.x);
        EpiRes E{X, MOD + 5120};
        pg8::gemm_phase<EpiRes, pg8::StaticOrder, true, true>(ring, g, S, E);
        SEpiRes SE{X, MOD + 5120}; sgemm_units<1>(C, (const bf16*)(ws + WS_U) + (size_t)MP * FF, FF, (const bf16*)(ws + WS_WDOWN), FF, DM / 16, SE); } SEAM(11);
    if (IN(12)) REP(12) { norm_rows(P, C, P.g_norm1 + DM, 7168, 6144, XN, P.g_kv_in, 13312, 12288, XN2); } SEAM(12);
    if (IN(13)) REP(13) {
        { pg8::Gemm g{XN2, (const bf16*)(ws + WS_WDKV), MP, 512, DM}; pg8::StaticOrder S; S.init(MP, 512, C.G, (int)blockIdx.x);
          EpiF32 E{(float*)(ws + WS_LAT), 512}; pg8::gemm_phase<EpiF32, pg8::StaticOrder, true, true>(ring, g, S, E); }
        { pg8::Gemm g{XN, (const bf16*)(ws + WS_WDQ), MP, 512, DM}; pg8::StaticOrder S; S.init(MP, 512, C.G, ((int)blockIdx.x + C.G / 2) % C.G);
          EpiF32 E{(float*)(ws + WS_QLAT), 512}; pg8::gemm_phase<EpiF32, pg8::StaticOrder, true, true>(ring, g, S, E); }
        { SEpiF32 SE{(float*)(ws + WS_LAT), 512}; sgemm_units<2>(C, XN2 + (size_t)MP * DM, DM, (const bf16*)(ws + WS_WDKV), DM, 288 / 32, SE); }
        { SEpiF32 SE{(float*)(ws + WS_QLAT), 512}; sgemm_units<2>(C, XN + (size_t)MP * DM, DM, (const bf16*)(ws + WS_WDQ), DM, 384 / 32, SE); } } SEAM(13);
    if (IN(14)) REP(14) { latent_rows(P, C); } SEAM(14);
    if (IN(15)) REP(15) {
        { pg8::Gemm g{(const bf16*)(ws + WS_QN), (const bf16*)(ws + WS_WUQ), MP, QW, 384}; pg8::StaticOrder S; S.init(MP, QW, C.G, (int)blockIdx.x);
          pg8::EpiBf16<0> E{(bf16*)(ws + WS_Q), QW, nullptr, 0, 0, 1.f}; pg8::gemm_phase<pg8::EpiBf16<0>, pg8::StaticOrder, true, true>(ring, g, S, E); }
        { pg8::Gemm g{(const bf16*)(ws + WS_CKV), (const bf16*)(ws + WS_WKV), MP, 2048, 256}; pg8::StaticOrder S; S.init(MP, 2048, C.G, ((int)blockIdx.x + C.G / 2) % C.G);
          pg8::EpiBf16<0> E{(bf16*)(ws + WS_KN), DM, nullptr, 1024, (size_t)(WS_V - WS_KN) / 2, 1.f}; pg8::gemm_phase<pg8::EpiBf16<0>, pg8::StaticOrder, true, true>(ring, g, S, E); }
        { SEpiBf16 SE{(bf16*)(ws + WS_Q), QW}; sgemm_units<2>(C, (const bf16*)(ws + WS_QN) + (size_t)MP * 384, 384, (const bf16*)(ws + WS_WUQ), 384, QW / 32, SE); } } SEAM(15);
    if (IN(16)) REP(16) {
        const bf16* Qb = (const bf16*)(ws + WS_Q); const bf16* KNb = (const bf16*)(ws + WS_KN); const bf16* KPb = (const bf16*)(ws + WS_KPE); const bf16* Vb = (const bf16*)(ws + WS_V);
        if (C.G == 256) { const int bhh = C.vcu >> 3, s = C.vcu & 7;
            for (int i = 0; i < 4; ++i) { const int qb = (i == 0) ? s : (i == 1) ? 15 - s : (i == 2) ? 16 + s : 31 - s; att::attn_unit(bhh >> 4, bhh & 15, qb, Qb, KNb, KPb, Vb, XN, (const float*)(ws + WS_ROPE), ring); } }
        else { for (int u = C.vcu; u < 1024; u += C.G) att::attn_unit(u >> 9, (u >> 5) & 15, u & 31, Qb, KNb, KPb, Vb, XN, (const float*)(ws + WS_ROPE), ring); } } SEAM(16);
    if (IN(17)) REP(17) { for (int u = C.vcu; u < 256; u += C.G) dec::decode_unit(P, C, u >> 1, u & 1); } SEAM(17);
    if (IN(18)) REP(18) { for (int u = C.vcu; u < NS; u += C.G) dec::combine_unit(P, C, u); } SEAM(18);
    if (IN(19)) REP(19) { pg8::Gemm g{XN, (const bf16*)(ws + WS_WO), MP, DM, DM}; pg8::StaticOrder S; S.init(MP, DM, C.G, (int)blockIdx.x);
        EpiRes E{X, MOD + 8192};
        pg8::gemm_phase<EpiRes, pg8::StaticOrder, true, true>(ring, g, S, E);
        SEpiRes SE{X, MOD + 8192}; sgemm_units<1>(C, XN + (size_t)MP * DM, DM, (const bf16*)(ws + WS_WO), DM, DM / 16, SE); } SEAM(19);
    if (IN(20)) REP(20) { norm_rows(P, C, P.g_norm2 + DM, 10240, 9216, XN, nullptr, 0, 0, nullptr); } SEAM(20);
    if (IN(21)) REP(21) { pg8::Gemm g{XN, (const bf16*)(ws + WS_WUP) + (size_t)FF2 * DM, MP, FF2, DM}; pg8::StaticOrder S; S.init(MP, FF2, C.G, (int)blockIdx.x);
        EpiUpConv E{(bf16*)(ws + WS_U), (bf16*)(ws + WS_HALO), (bf16*)(ws + WS_FIXA), (bf16*)(ws + WS_FIXG), P.w_conv + (size_t)1 * 3 * FF, P.b_conv + (size_t)1 * FF};
        pg8::gemm_phase<EpiUpConv, pg8::StaticOrder, true, true>(ring, g, S, E);
        SEpiUpConv SE{(bf16*)(ws + WS_U), P.w_conv + (size_t)1 * 3 * FF, P.b_conv + (size_t)1 * FF, P.st_conv + (size_t)1 * NS * 2 * FF, P.out + O_CONVS + (size_t)1 * NS * 2 * FF};
        sgemm_units<2>(C, XN + (size_t)MP * DM, DM, (const bf16*)(ws + WS_WUP) + (size_t)FF2 * DM, DM, FF / 16, SE); } SEAM(21);
    if (IN(22)) REP(22) { conv_fixup(P, C, 1); } SEAM(22);
    if (IN(23)) REP(23) { pg8::Gemm g{(const bf16*)(ws + WS_U), (const bf16*)(ws + WS_WDOWN) + (size_t)DM * FF, MP, DM, FF}; pg8::StaticOrder S; S.init(MP, DM, C.G, (int)blockIdx.x);
        EpiRes E{X, MOD + 11264};
        pg8::gemm_phase<EpiRes, pg8::StaticOrder, true, true>(ring, g, S, E);
        SEpiRes SE{X, MOD + 11264}; sgemm_units<1>(C, (const bf16*)(ws + WS_U) + (size_t)MP * FF, FF, (const bf16*)(ws + WS_WDOWN) + (size_t)DM * FF, FF, DM / 16, SE); } SEAM(23);
    if (IN(24)) REP(24) { final_norm(P, C); }
#undef IN
#undef SEAM
}

extern "C" void kernel_launch(void* const* d_in, const int* in_sizes, int n_in, void* d_out, int out_size, void* d_ws, size_t ws_size, hipStream_t stream) {
    static int grid = 0;
    if (grid == 0) {
        if (n_in != 35 || out_size != (int)O_END || ws_size < WS_END) { fprintf(stderr, "kernel_launch: unexpected shapes (n_in %d, out %d, ws %zu < %zu); nothing launched\n", n_in, out_size, ws_size, (size_t)WS_END); grid = -1; return; }
        int dev = 0, cus = 0, per_cu = 0;
        if (hipGetDevice(&dev) != hipSuccess || hipDeviceGetAttribute(&cus, hipDeviceAttributeMultiprocessorCount, dev) != hipSuccess) { grid = -1; return; }
        if (hipFuncSetAttribute((const void*)mk_fwd, hipFuncAttributeMaxDynamicSharedMemorySize, LDS_BYTES) != hipSuccess) { fprintf(stderr, "kernel_launch: hipFuncSetAttribute failed\n"); grid = -1; return; }
        if (hipOccupancyMaxActiveBlocksPerMultiprocessor(&per_cu, (const void*)mk_fwd, NTHREADS, LDS_BYTES) != hipSuccess || per_cu < 1)
            fprintf(stderr, "kernel_launch: note: occupancy query reports %d workgroups per CU\n", per_cu);
        (void)hipGetLastError();
        grid = cus;
    }
    if (grid < 0) return;
    if (hipMemsetAsync((char*)d_ws + WS_CTL, 0, CTL_ZERO_BYTES, stream) != hipSuccess) { fprintf(stderr, "kernel_launch: memset failed\n"); return; }
    Params p{};
    p.x_p = (const float*)d_in[0]; p.x_s = (const float*)d_in[1]; p.st_C = (const float*)d_in[2]; p.st_n = (const float*)d_in[3]; p.st_m = (const float*)d_in[4]; p.st_conv = (const float*)d_in[5];
    p.cache_ckv = (const float*)d_in[6]; p.cache_kpe = (const float*)d_in[7]; p.page_table = (const int*)d_in[8]; p.c_p = (const float*)d_in[9]; p.c_s = (const float*)d_in[10];
    p.g_norm1 = (const float*)d_in[11]; p.g_norm2 = (const float*)d_in[12]; p.w_ada = (const float*)d_in[13]; p.b_ada = (const float*)d_in[14]; p.w_up = (const float*)d_in[15];
    p.w_conv = (const float*)d_in[16]; p.b_conv = (const float*)d_in[17]; p.w_down = (const float*)d_in[18]; p.w_m_in = (const float*)d_in[19]; p.b_m_gates = (const float*)d_in[20];
    p.g_m_head = (const float*)d_in[21]; p.w_m_out = (const float*)d_in[22]; p.g_kv_in = (const float*)d_in[23]; p.w_ada_kv = (const float*)d_in[24]; p.b_ada_kv = (const float*)d_in[25];
    p.w_dkv = (const float*)d_in[26]; p.g_kv = (const float*)d_in[27]; p.w_uk = (const float*)d_in[28]; p.w_uv = (const float*)d_in[29]; p.w_dq = (const float*)d_in[30];
    p.g_q = (const float*)d_in[31]; p.w_uq = (const float*)d_in[32]; p.w_o = (const float*)d_in[33]; p.g_final = (const float*)d_in[34];
    p.out = (float*)d_out; p.ws = (unsigned char*)d_ws;
#if MK_ONE_LAUNCH
#ifdef PREFIX_K
    p.ph_lo = 0; p.ph_hi = PREFIX_K;
#ifdef PREFIX_VAR
    p.var = PREFIX_VAR;
#endif
    hipLaunchKernelGGL(mk_fwd, dim3(grid), dim3(NTHREADS), LDS_BYTES, stream, p);
    (void)hipMemsetAsync((char*)d_ws + WS_CTL, 0, CTL_ZERO_BYTES, stream);
#endif
    p.ph_lo = 0; p.ph_hi = N_PHASES; p.var = 0;
    hipLaunchKernelGGL(mk_fwd, dim3(grid), dim3(NTHREADS), LDS_BYTES, stream, p);
#else
    for (int ph = 0; ph < N_PHASES; ++ph) { p.ph_lo = ph; p.ph_hi = ph + 1; hipLaunchKernelGGL(mk_fwd, dim3(grid), dim3(NTHREADS), LDS_BYTES, stream, p); }
#endif
    const hipError_t le = hipPeekAtLastError();
    if (le != hipSuccess) fprintf(stderr, "kernel_launch: launch failed: %s\n", hipGetErrorName(le));
}
```
